# Optimizing an MI355X kernel written in HIP

```python
import math
import jax, jax.numpy as jnp
from jax import lax
import numpy as np

D_MODEL = 1024
BATCH = 4
SEQ = 4096
DEPTH = 1

HEAD_DIM = 64
FOX_HEADS = 8
FOX_WIDTH = FOX_HEADS * HEAD_DIM
DIFF_HEADS = 4
DIFF_QK_DIM = HEAD_DIM
DIFF_QK_WIDTH = DIFF_HEADS * 2 * DIFF_QK_DIM
DIFF_V_DIM = 2 * HEAD_DIM
DIFF_WIDTH = DIFF_HEADS * DIFF_V_DIM
MEM_HEADS = 4
MEM_HEAD_DIM = 128
MEM_WIDTH = MEM_HEADS * MEM_HEAD_DIM
N_MEM = 256
N_BRANCH = 3
Q_BLOCK = 128
N_GROUPS = 4
EXPERTS_PER_GROUP = 8
N_EXPERTS = N_GROUPS * EXPERTS_PER_GROUP
TOP_K_INNER = 2
D_EXPERT = 256
LN_EPS = 1e-5
FORGET_BIAS_OFFSET = 2.0
DEEPNORM_ALPHA = (2.0 * DEPTH) ** 0.25
DEEPNORM_BETA = (8.0 * DEPTH) ** -0.25
IN_SPLITS = (FOX_WIDTH, FOX_WIDTH, FOX_WIDTH,
             DIFF_QK_WIDTH, DIFF_QK_WIDTH, DIFF_WIDTH,
             MEM_WIDTH,
             N_BRANCH * D_MODEL,
             FOX_HEADS)
IN_COLS = sum(IN_SPLITS)
IN_OFFSETS = [int(o) for o in np.cumsum(IN_SPLITS)[:-1]]

kernel_name = "hybrid_fox_diff_mem_hmoe_deepnorm"


def layer_norm(x, g, b):
    xf = x.astype(jnp.float32)
    mu = jnp.mean(xf, axis=-1, keepdims=True)
    var = jnp.mean(jnp.square(xf - mu), axis=-1, keepdims=True)
    return ((xf - mu) * lax.rsqrt(var + LN_EPS) * g + b).astype(x.dtype)


def rms_norm(x, g):
    xf = x.astype(jnp.float32)
    return (xf * lax.rsqrt(jnp.mean(jnp.square(xf), axis=-1, keepdims=True) + LN_EPS) * g).astype(x.dtype)


def _to_blocks(a):
    b, h, s = a.shape[:3]
    a = a.reshape((b, h, s // Q_BLOCK, Q_BLOCK) + a.shape[3:])
    return jnp.moveaxis(a, 2, 0)


def _from_blocks(o):
    nb, b, h, blk, dv = o.shape
    o = jnp.moveaxis(o, 0, 2).reshape(b, h, nb * blk, dv)
    return jnp.transpose(o, (0, 2, 1, 3))


def fox_attention(q, k, v, log_f):
    s_len = q.shape[2]
    c = jnp.cumsum(log_f, axis=-1)
    pos = jnp.arange(s_len)
    scale = HEAD_DIM ** -0.5

    def block(args):
        qb, cb, pb = args
        logits = jnp.einsum('bhqd,bhkd->bhqk', qb, k).astype(jnp.float32) * scale
        logits = logits + (cb[..., None] - c[:, :, None, :])
        causal = pb[:, None] >= pos[None, :]
        p = jax.nn.softmax(jnp.where(causal, logits, -jnp.inf), axis=-1)
        return jnp.einsum('bhqk,bhkd->bhqd', p.astype(v.dtype), v)

    out = lax.map(block, (_to_blocks(q), _to_blocks(c), pos.reshape(-1, Q_BLOCK)))
    return _from_blocks(out)


def diff_attention(q1, q2, k1, k2, v, lam, slopes):
    s_len = q1.shape[2]
    pos = jnp.arange(s_len)
    scale = DIFF_QK_DIM ** -0.5

    def block(args):
        q1b, q2b, pb = args
        dist = (pb[:, None] - pos[None, :]).astype(jnp.float32)
        bias = -slopes[:, None, None] * dist
        causal = dist >= 0

        def probs(qb, kk):
            lg = jnp.einsum('bhqd,bhkd->bhqk', qb, kk).astype(jnp.float32) * scale + bias
            return jax.nn.softmax(jnp.where(causal, lg, -jnp.inf), axis=-1)

        p = probs(q1b, k1) - lam * probs(q2b, k2)
        return jnp.einsum('bhqk,bhkd->bhqd', p.astype(v.dtype), v)

    out = lax.map(block, (_to_blocks(q1), _to_blocks(q2), pos.reshape(-1, Q_BLOCK)))
    return _from_blocks(out)


def memory_attention(q, km, vm):
    logits = jnp.einsum('bhqd,bhmd->bhqm', q, km).astype(jnp.float32) * (MEM_HEAD_DIM ** -0.5)
    p = jax.nn.softmax(logits, axis=-1)
    out = jnp.einsum('bhqm,bhmd->bhqd', p.astype(vm.dtype), vm)
    return jnp.transpose(out, (0, 2, 1, 3))


def hier_moe(x, w_rg, b_rg, w_re, b_re, w_gate, w_up, w_down):
    b, s, d = x.shape
    xt = x.reshape(b * s, d)
    g_prob = jax.nn.softmax((xt @ w_rg + b_rg).astype(jnp.float32), axis=-1)
    g_w, g_idx = lax.top_k(g_prob, 1)
    e_logits = (xt @ w_re + b_re).astype(jnp.float32).reshape(-1, N_GROUPS, EXPERTS_PER_GROUP)
    e_logits = jnp.take_along_axis(e_logits, g_idx[:, :, None], axis=1)[:, 0]
    e_w, e_idx = lax.top_k(jax.nn.softmax(e_logits, axis=-1), TOP_K_INNER)
    e_w = e_w / jnp.sum(e_w, axis=-1, keepdims=True)
    w = g_w * e_w
    expert_id = g_idx * EXPERTS_PER_GROUP + e_idx
    combine = jnp.sum(jax.nn.one_hot(expert_id, N_EXPERTS, dtype=jnp.float32) * w[..., None], axis=1)
    acc = jnp.zeros_like(xt)
    for e in range(N_EXPERTS):
        y = (jax.nn.silu(xt @ w_gate[e]) * (xt @ w_up[e])) @ w_down[e]
        acc = acc + combine[:, e:e + 1].astype(xt.dtype) * y
    return acc.reshape(b, s, d)


def setup_inputs(seed: int = 0) -> dict:
    key = jax.random.key(seed)
    ks = jax.random.split(key, 24)
    L, D = DEPTH, D_MODEL
    f32 = jnp.float32

    def nrm(k, shape, scale):
        return jax.random.normal(k, shape, f32) * scale

    beta = DEEPNORM_BETA
    col_scale = jnp.concatenate([
        jnp.ones((2 * FOX_WIDTH,), f32), jnp.full((FOX_WIDTH,), beta, f32),
        jnp.ones((2 * DIFF_QK_WIDTH,), f32), jnp.full((DIFF_WIDTH,), beta, f32),
        jnp.ones((MEM_WIDTH + N_BRANCH * D + FOX_HEADS,), f32)])
    mem_scale = jnp.concatenate([jnp.ones((MEM_WIDTH,), f32), jnp.full((MEM_WIDTH,), beta, f32)])
    return {
        "x": nrm(ks[0], (BATCH, SEQ, D), 1.0),
        "mem": nrm(ks[1], (BATCH, N_MEM, D), 1.0),
        "w_in": nrm(ks[2], (L, D, IN_COLS), D ** -0.5) * col_scale,
        "b_forget": FORGET_BIAS_OFFSET + nrm(ks[3], (L, FOX_HEADS), 0.5),
        "b_gates": nrm(ks[4], (L, N_BRANCH * D), 0.02),
        "lambda_q1": nrm(ks[5], (L, DIFF_QK_DIM), 0.1),
        "lambda_k1": nrm(ks[6], (L, DIFF_QK_DIM), 0.1),
        "lambda_q2": nrm(ks[7], (L, DIFF_QK_DIM), 0.1),
        "lambda_k2": nrm(ks[8], (L, DIFF_QK_DIM), 0.1),
        "diff_subln_g": 1.0 + nrm(ks[9], (L, DIFF_V_DIM), 0.02),
        "w_mem_kv": nrm(ks[10], (L, D, 2 * MEM_WIDTH), D ** -0.5) * mem_scale,
        "w_branch_fox": nrm(ks[11], (L, FOX_WIDTH, D), beta * FOX_WIDTH ** -0.5),
        "w_branch_diff": nrm(ks[12], (L, DIFF_WIDTH, D), beta * DIFF_WIDTH ** -0.5),
        "w_branch_mem": nrm(ks[13], (L, MEM_WIDTH, D), beta * MEM_WIDTH ** -0.5),
        "w_out": nrm(ks[14], (L, D, D), beta * D ** -0.5),
        "ln1_g": 1.0 + nrm(ks[15], (L, D), 0.02),
        "ln1_b": nrm(ks[16], (L, D), 0.02),
        "w_router_group": nrm(ks[17], (L, D, N_GROUPS), D ** -0.5),
        "b_router_group": nrm(ks[18], (L, N_GROUPS), 0.01),
        "w_router_expert": nrm(ks[19], (L, D, N_EXPERTS), D ** -0.5),
        "b_router_expert": nrm(ks[20], (L, N_EXPERTS), 0.01),
        "w_expert_gate": nrm(ks[21], (L, N_EXPERTS, D, D_EXPERT), beta * D ** -0.5),
        "w_expert_up": nrm(ks[22], (L, N_EXPERTS, D, D_EXPERT), beta * D ** -0.5),
        "w_expert_down": nrm(ks[23], (L, N_EXPERTS, D_EXPERT, D), beta * D_EXPERT ** -0.5),
        "ln2_g": 1.0 + nrm(jax.random.fold_in(key, 101), (L, D), 0.02),
        "ln2_b": nrm(jax.random.fold_in(key, 102), (L, D), 0.02),
    }


def reference(x, mem, w_in, b_forget, b_gates, lambda_q1, lambda_k1, lambda_q2, lambda_k2,
              diff_subln_g, w_mem_kv, w_branch_fox, w_branch_diff, w_branch_mem, w_out,
              ln1_g, ln1_b, w_router_group, b_router_group, w_router_expert, b_router_expert,
              w_expert_gate, w_expert_up, w_expert_down, ln2_g, ln2_b):
    B, S, D = x.shape
    slopes = 2.0 ** (-8.0 * jnp.arange(1, DIFF_HEADS + 1, dtype=jnp.float32) / DIFF_HEADS)
    for l in range(DEPTH):
        proj = x @ w_in[l]
        fq, fk, fv, dq, dk, dv, mq, gl, fl = jnp.split(proj, IN_OFFSETS, axis=-1)

        heads = lambda t, h, d: jnp.transpose(t.reshape(B, S, h, d), (0, 2, 1, 3))
        log_f = jax.nn.log_sigmoid((fl + b_forget[l]).astype(jnp.float32))
        y_fox = fox_attention(heads(fq, FOX_HEADS, HEAD_DIM), heads(fk, FOX_HEADS, HEAD_DIM),
                              heads(fv, FOX_HEADS, HEAD_DIM), jnp.transpose(log_f, (0, 2, 1)))
        y_fox = y_fox.reshape(B, S, FOX_WIDTH)

        lam_init = 0.8 - 0.6 * math.exp(-0.3 * l)
        lam = (jnp.exp(jnp.sum(lambda_q1[l] * lambda_k1[l]).astype(jnp.float32))
               - jnp.exp(jnp.sum(lambda_q2[l] * lambda_k2[l]).astype(jnp.float32)) + lam_init)
        dq = jnp.transpose(dq.reshape(B, S, DIFF_HEADS, 2, DIFF_QK_DIM), (0, 2, 1, 3, 4))
        dk = jnp.transpose(dk.reshape(B, S, DIFF_HEADS, 2, DIFF_QK_DIM), (0, 2, 1, 3, 4))
        y_diff = diff_attention(dq[..., 0, :], dq[..., 1, :], dk[..., 0, :], dk[..., 1, :],
                                heads(dv, DIFF_HEADS, DIFF_V_DIM), lam, slopes)
        y_diff = (rms_norm(y_diff, diff_subln_g[l]) * (1.0 - lam_init)).reshape(B, S, DIFF_WIDTH)

        mkv = mem @ w_mem_kv[l]
        mk, mv = jnp.split(mkv, 2, axis=-1)
        mem_heads = lambda t: jnp.transpose(t.reshape(B, N_MEM, MEM_HEADS, MEM_HEAD_DIM), (0, 2, 1, 3))
        y_mem = memory_attention(heads(mq, MEM_HEADS, MEM_HEAD_DIM), mem_heads(mk), mem_heads(mv))
        y_mem = y_mem.reshape(B, S, MEM_WIDTH)

        gates = jax.nn.sigmoid(gl + b_gates[l]).reshape(B, S, N_BRANCH, D)
        h = (gates[:, :, 0] * (y_fox @ w_branch_fox[l])
             + gates[:, :, 1] * (y_diff @ w_branch_diff[l])
             + gates[:, :, 2] * (y_mem @ w_branch_mem[l]))
        x = layer_norm(DEEPNORM_ALPHA * x + h @ w_out[l], ln1_g[l], ln1_b[l])

        m = hier_moe(x, w_router_group[l], b_router_group[l], w_router_expert[l], b_router_expert[l],
                     w_expert_gate[l], w_expert_up[l], w_expert_down[l])
        x = layer_norm(DEEPNORM_ALPHA * x + m, ln2_g[l], ln2_b[l])
    return x
```

```cpp
#include <hip/hip_runtime.h>
#include <cstdio>
#include <cstdint>

typedef unsigned short bf16_t;
typedef unsigned int u32;

constexpr int T = 16384, DM = 1024, NB = 4, SEQ = 4096, NMEM = 256;
constexpr int NQKV = 3584, NGATE = 3072, NPROJ = 6656, INCOLS = 6664;
constexpr int NEXP = 32, DEXP = 256;
constexpr float LN_EPS = 1e-5f;
constexpr float LOG2E = 1.4426950408889634f;
constexpr float C2 = 0.125f * LOG2E;
constexpr float C2M = 0.08838834764831845f * LOG2E;
constexpr float ALPHA = 1.189207115002721f;
constexpr float LAM_INIT = 0.2f;
constexpr int C_FQ = 0, C_FK = 512, C_FV = 1024, C_DQ = 1536, C_DK = 2048, C_DV = 2560, C_MQ = 3072;

constexpr size_t MiB = 1u << 20;
constexpr size_t WS_CTL = 0, CTL_ZERO_BYTES = 1 * MiB;
constexpr size_t WS_WBR_T = 1 * MiB;
constexpr size_t WS_WOUT_T = 4 * MiB;
constexpr size_t WS_FBIAS = 6 * MiB;
constexpr size_t WS_LOGF = 6 * MiB + 512 * 1024;
constexpr size_t WS_MEMK = 7 * MiB;
constexpr size_t WS_MEMVT = 8 * MiB;
constexpr size_t WS_ROUTE = 9 * MiB;
constexpr size_t WS_LISTS = 10 * MiB;
constexpr size_t WS_QKV = 16 * MiB;
constexpr size_t WS_GATES = 128 * MiB;
constexpr size_t WS_HB = 224 * MiB;
constexpr size_t WS_DPART = 224 * MiB;
constexpr size_t WS_WGU_T = 16 * MiB;
constexpr size_t WS_WD_T = 48 * MiB;
constexpr size_t WS_X1B = 64 * MiB;
constexpr size_t WS_ACT = 96 * MiB;
constexpr size_t WS_YBUF = 128 * MiB;
constexpr size_t WS_END = 256 * MiB;
constexpr size_t DO_XB = 0;
constexpr size_t DO_WIN_T = 32 * MiB;
constexpr size_t DO_MEMB = 45 * MiB;
constexpr size_t DO_WMKV_T = 47 * MiB;
constexpr size_t DO_YFOX = 0;
constexpr size_t DO_YMEM = 16 * MiB;
constexpr size_t DO_YDIFF = 32 * MiB;
constexpr int CW_CNT = 1024;

__device__ __forceinline__ u32 f2bf(float f) { u32 u = __builtin_bit_cast(u32, f); return (u + 0x7fffu + ((u >> 16) & 1u)) >> 16; }
__device__ __forceinline__ float bf2f(bf16_t b) { return __builtin_bit_cast(float, (u32)b << 16); }
__device__ __forceinline__ float wave_sum(float v) {
#pragma unroll
    for (int o = 1; o < 64; o <<= 1) v += __shfl_xor(v, o);
    return v;
}
__device__ __forceinline__ float wave_max(float v) {
#pragma unroll
    for (int o = 1; o < 64; o <<= 1) v = fmaxf(v, __shfl_xor(v, o));
    return v;
}
__device__ __forceinline__ float lam_value(const float* q1, const float* k1, const float* q2, const float* k2) {
    float s1 = 0.f, s2 = 0.f;
    for (int i = 0; i < 64; ++i) { s1 += q1[i] * k1[i]; s2 += q2[i] * k2[i]; }
    return __expf(s1) - __expf(s2) + LAM_INIT;
}

__global__ void k_cvt(const float* __restrict__ src, bf16_t* __restrict__ dst, size_t n4) {
    for (size_t i = (size_t)blockIdx.x * blockDim.x + threadIdx.x; i < n4; i += (size_t)gridDim.x * blockDim.x) {
        const float4 v = ((const float4*)src)[i];
        uint2 o; o.x = f2bf(v.x) | (f2bf(v.y) << 16); o.y = f2bf(v.z) | (f2bf(v.w) << 16);
        ((uint2*)dst)[i] = o;
    }
}
__global__ void k_transpose_cvt(const float* __restrict__ W, size_t wbatch, int K, int N, int ldw, int col0, bf16_t* __restrict__ Wt, size_t tbatch, int mode) {
    __shared__ float tile[32][33];
    const float* Wb = W + wbatch * blockIdx.z; bf16_t* Tb = Wt + tbatch * blockIdx.z;
    const int n0 = blockIdx.x * 32, k0 = blockIdx.y * 32, tx = threadIdx.x & 31, ty = threadIdx.x >> 5;
    for (int i = ty; i < 32; i += 8) tile[i][tx] = Wb[(size_t)(k0 + i) * ldw + col0 + n0 + tx];
    __syncthreads();
    for (int i = ty; i < 32; i += 8) {
        const int n = n0 + i; int r = n;
        if (mode == 1) r = 256 * (n >> 7) + (n & 127);
        if (mode == 2) r = 256 * (n >> 7) + 128 + (n & 127);
        Tb[(size_t)r * K + k0 + tx] = (bf16_t)f2bf(tile[tx][i]);
    }
}
__global__ void k_forget(const float* __restrict__ x, const float* __restrict__ w_in, const float* __restrict__ b_forget, float* __restrict__ logf) {
    const int lane = threadIdx.x & 63, t = blockIdx.x * (blockDim.x >> 6) + (threadIdx.x >> 6);
    if (t >= T) return;
    float a[8];
#pragma unroll
    for (int h = 0; h < 8; ++h) a[h] = 0.f;
    for (int i = 0; i < 16; ++i) {
        const int k = lane + 64 * i; const float xv = x[(size_t)t * DM + k];
        const float4 w0 = *(const float4*)(w_in + (size_t)k * INCOLS + NPROJ), w1 = *(const float4*)(w_in + (size_t)k * INCOLS + NPROJ + 4);
        a[0] += xv * w0.x; a[1] += xv * w0.y; a[2] += xv * w0.z; a[3] += xv * w0.w; a[4] += xv * w1.x; a[5] += xv * w1.y; a[6] += xv * w1.z; a[7] += xv * w1.w;
    }
#pragma unroll
    for (int h = 0; h < 8; ++h) a[h] = wave_sum(a[h]);
    if (lane < 8) {
        float z = 0.f;
#pragma unroll
        for (int h = 0; h < 8; ++h) if (lane == h) z = a[h];
        z += b_forget[lane];
        logf[(size_t)t * 8 + lane] = fminf(z, 0.f) - log1pf(__expf(-fabsf(z)));
    }
}
__global__ void k_cumsum(const float* __restrict__ logf, float* __restrict__ fbias) {
    const int lane = threadIdx.x, bh = blockIdx.x, b = bh >> 3, h = bh & 7;
    float loc = 0.f;
    for (int i = 0; i < 64; ++i) loc += logf[((size_t)b * SEQ + lane * 64 + i) * 8 + h];
    float inc = loc;
#pragma unroll
    for (int o = 1; o < 64; o <<= 1) { const float v = __shfl_up(inc, o); if (lane >= o) inc += v; }
    float run = inc - loc;
    for (int i = 0; i < 64; ++i) { run += logf[((size_t)b * SEQ + lane * 64 + i) * 8 + h]; fbias[(size_t)bh * SEQ + lane * 64 + i] = -run * LOG2E; }
}

struct GemmP {
    const bf16_t* A; const bf16_t* Bt; int M, N, K, lda, ldb;
    bf16_t* o0; bf16_t* o1; const bf16_t* g; const float* bias; const float* xres; float* of; int aux;
};
enum { MODE_PROJ = 0, MODE_BF16 = 1, MODE_BRANCH = 2, MODE_OUT = 3 };
template <int MODE> __device__ __forceinline__ void gemm_epi(const GemmP& p, int m, int n, float acc) {
    if (MODE == MODE_PROJ) {
        if (n < NQKV) { float sc = 1.f; if (n < 512 || (n >= C_DQ && n < C_DK)) sc = C2; else if (n >= C_MQ) sc = C2M; p.o0[(size_t)m * NQKV + n] = (bf16_t)f2bf(acc * sc); }
        else p.o1[(size_t)m * NGATE + (n - NQKV)] = (bf16_t)f2bf(acc);
    } else if (MODE == MODE_BF16) {
        p.o0[(size_t)m * p.N + n] = (bf16_t)f2bf(acc);
    } else if (MODE == MODE_BRANCH) {
        const int i = p.aux; const float gl = bf2f(p.g[(size_t)m * NGATE + i * DM + n]) + p.bias[i * DM + n];
        const float v = acc / (1.f + __expf(-gl));
        bf16_t* hp = p.o0 + (size_t)m * DM + n;
        *hp = (bf16_t)f2bf(i == 0 ? v : bf2f(*hp) + v);
    } else if (MODE == MODE_OUT) {
        p.of[(size_t)m * DM + n] = ALPHA * p.xres[(size_t)m * DM + n] + acc;
    }
}
template <int MODE> __global__ void __launch_bounds__(256) k_gemm_naive(GemmP p) {
    __shared__ float As[16][65], Bs[16][65];
    const int m0 = blockIdx.y * 64, n0 = blockIdx.x * 64, tid = threadIdx.x, tx = tid & 15, ty = tid >> 4;
    float acc[4][4];
#pragma unroll
    for (int i = 0; i < 4; ++i)
#pragma unroll
        for (int j = 0; j < 4; ++j) acc[i][j] = 0.f;
    const int lr = tid >> 2, lc = (tid & 3) * 4;
    for (int k0 = 0; k0 < p.K; k0 += 16) {
        const uint2 av = *(const uint2*)(p.A + (size_t)(m0 + lr) * p.lda + k0 + lc);
        const uint2 bv = *(const uint2*)(p.Bt + (size_t)(n0 + lr) * p.ldb + k0 + lc);
        As[lc + 0][lr] = bf2f((bf16_t)(av.x & 0xffff)); As[lc + 1][lr] = bf2f((bf16_t)(av.x >> 16)); As[lc + 2][lr] = bf2f((bf16_t)(av.y & 0xffff)); As[lc + 3][lr] = bf2f((bf16_t)(av.y >> 16));
        Bs[lc + 0][lr] = bf2f((bf16_t)(bv.x & 0xffff)); Bs[lc + 1][lr] = bf2f((bf16_t)(bv.x >> 16)); Bs[lc + 2][lr] = bf2f((bf16_t)(bv.y & 0xffff)); Bs[lc + 3][lr] = bf2f((bf16_t)(bv.y >> 16));
        __syncthreads();
#pragma unroll
        for (int kk = 0; kk < 16; ++kk) {
            float a[4], b[4];
#pragma unroll
            for (int i = 0; i < 4; ++i) { a[i] = As[kk][ty * 4 + i]; b[i] = Bs[kk][tx * 4 + i]; }
#pragma unroll
            for (int i = 0; i < 4; ++i)
#pragma unroll
                for (int j = 0; j < 4; ++j) acc[i][j] += a[i] * b[j];
        }
        __syncthreads();
    }
#pragma unroll
    for (int i = 0; i < 4; ++i)
#pragma unroll
        for (int j = 0; j < 4; ++j) gemm_epi<MODE>(p, m0 + ty * 4 + i, n0 + tx * 4 + j, acc[i][j]);
}

struct AttnP { const bf16_t* qkv; const float* fbias; bf16_t* yfox; bf16_t* dpart; };
__global__ void __launch_bounds__(64) k_attn_naive(AttnP p) {
    __shared__ float lg[SEQ]; __shared__ float qs[64];
    const int lane = threadIdx.x, t = blockIdx.x, he = blockIdx.y, b = t / SEQ, qpos = t % SEQ;
    int qcol, kcol, vcol; const float* brow = nullptr; float slope2 = 0.f; bf16_t* outp;
    if (he < 8) { qcol = C_FQ + 64 * he; kcol = C_FK + 64 * he; vcol = C_FV + 64 * he; brow = p.fbias + (size_t)(b * 8 + he) * SEQ; outp = p.yfox + (size_t)t * 512 + 64 * he; }
    else { const int e = he - 8, h = e >> 2, i = (e >> 1) & 1, j = e & 1; qcol = C_DQ + 128 * h + 64 * i; kcol = C_DK + 128 * h + 64 * i; vcol = C_DV + 128 * h + 64 * j;
           slope2 = exp2f(-2.f * (h + 1)) * LOG2E; outp = p.dpart + (size_t)t * 1024 + e * 64; }
    qs[lane] = bf2f(p.qkv[(size_t)t * NQKV + qcol + lane]);
    __syncthreads();
    const bf16_t* kb = p.qkv + (size_t)b * SEQ * NQKV + kcol; const bf16_t* vb = p.qkv + (size_t)b * SEQ * NQKV + vcol;
    float mx = -INFINITY;
    for (int s0 = 0; s0 <= qpos; s0 += 64) {
        const int s = s0 + lane; float d = -INFINITY;
        if (s <= qpos) { d = 0.f; const bf16_t* kr = kb + (size_t)s * NQKV;
            for (int c = 0; c < 64; c += 2) { const u32 w = *(const u32*)(kr + c); d += qs[c] * bf2f((bf16_t)(w & 0xffff)) + qs[c + 1] * bf2f((bf16_t)(w >> 16)); }
            d += brow ? brow[s] : slope2 * (float)(s - qpos); }
        lg[s] = d; mx = fmaxf(mx, d);
    }
    mx = wave_max(mx);
    float l = 0.f;
    const int nk = ((qpos >> 6) + 1) << 6;
    for (int s = lane; s < nk; s += 64) { const float pv = exp2f(lg[s] - mx); lg[s] = pv; l += pv; }
    l = wave_sum(l);
    __syncthreads();
    float o = 0.f;
    for (int s = 0; s <= qpos; ++s) o += lg[s] * bf2f(vb[(size_t)s * NQKV + lane]);
    outp[lane] = (bf16_t)f2bf(o / l);
}
__global__ void __launch_bounds__(64) k_memattn_naive(const bf16_t* __restrict__ qkv, const bf16_t* __restrict__ memk, const bf16_t* __restrict__ memvt, bf16_t* __restrict__ ymem) {
    __shared__ float qs[128]; __shared__ float pr[256];
    const int lane = threadIdx.x, t = blockIdx.x, h = blockIdx.y, b = t / SEQ;
    qs[lane] = bf2f(qkv[(size_t)t * NQKV + C_MQ + 128 * h + lane]); qs[lane + 64] = bf2f(qkv[(size_t)t * NQKV + C_MQ + 128 * h + 64 + lane]);
    __syncthreads();
    float lgv[4]; float mx = -INFINITY;
#pragma unroll
    for (int i = 0; i < 4; ++i) { const int m = lane + 64 * i; const bf16_t* kr = memk + (size_t)(b * 256 + m) * 512 + 128 * h; float d = 0.f;
        for (int c = 0; c < 128; ++c) d += qs[c] * bf2f(kr[c]);
        lgv[i] = d; mx = fmaxf(mx, d); }
    mx = wave_max(mx); float l = 0.f;
#pragma unroll
    for (int i = 0; i < 4; ++i) { const float pv = exp2f(lgv[i] - mx); pr[lane + 64 * i] = pv; l += pv; }
    l = wave_sum(l);
    __syncthreads();
#pragma unroll
    for (int i = 0; i < 2; ++i) { const int d = lane + 64 * i; const bf16_t* vr = memvt + (size_t)(128 * h + d) * 1024 + b * 256; float o = 0.f;
        for (int m = 0; m < 256; ++m) o += pr[m] * bf2f(vr[m]);
        ymem[(size_t)t * 512 + 128 * h + d] = (bf16_t)f2bf(o / l); }
}
__global__ void __launch_bounds__(256) k_diff_combine(const bf16_t* __restrict__ dpart, const float* q1, const float* k1, const float* q2, const float* k2, const float* __restrict__ g, bf16_t* __restrict__ ydiff) {
    const int lane = threadIdx.x & 63, w = blockIdx.x * 4 + (threadIdx.x >> 6), t = w >> 2, h = w & 3;
    const float lam = lam_value(q1, k1, q2, k2);
    const bf16_t* pp = dpart + (size_t)t * 1024 + h * 256;
    float v[2]; float ss = 0.f;
#pragma unroll
    for (int j = 0; j < 2; ++j) { v[j] = bf2f(pp[j * 64 + lane]) - lam * bf2f(pp[128 + j * 64 + lane]); ss += v[j] * v[j]; }
    ss = wave_sum(ss); const float r = rsqrtf(ss * (1.f / 128.f) + LN_EPS) * (1.f - LAM_INIT);
#pragma unroll
    for (int j = 0; j < 2; ++j) ydiff[(size_t)t * 512 + h * 128 + j * 64 + lane] = (bf16_t)f2bf(v[j] * r * g[j * 64 + lane]);
}

struct RouteP { float* x1; bf16_t* x1b; const float* g1; const float* b1; const float* wrg; const float* brg; const float* wre; const float* bre; u32* cnt; int* lists; u32* route; };
__global__ void __launch_bounds__(256) k_ln1_route(RouteP p) {
    const int lane = threadIdx.x & 63, t = blockIdx.x * 4 + (threadIdx.x >> 6);
    float4 v[4]; float s = 0.f;
    float* xr = p.x1 + (size_t)t * DM;
#pragma unroll
    for (int j = 0; j < 4; ++j) { v[j] = ((const float4*)xr)[lane + 64 * j]; s += (v[j].x + v[j].y) + (v[j].z + v[j].w); }
    const float mean = wave_sum(s) * (1.f / DM); float s2 = 0.f;
#pragma unroll
    for (int j = 0; j < 4; ++j) { v[j].x -= mean; v[j].y -= mean; v[j].z -= mean; v[j].w -= mean; s2 += (v[j].x * v[j].x + v[j].y * v[j].y) + (v[j].z * v[j].z + v[j].w * v[j].w); }
    const float rstd = rsqrtf(wave_sum(s2) * (1.f / DM) + LN_EPS);
#pragma unroll
    for (int j = 0; j < 4; ++j) { const float4 g = ((const float4*)p.g1)[lane + 64 * j], bb = ((const float4*)p.b1)[lane + 64 * j];
        v[j].x = v[j].x * rstd * g.x + bb.x; v[j].y = v[j].y * rstd * g.y + bb.y; v[j].z = v[j].z * rstd * g.z + bb.z; v[j].w = v[j].w * rstd * g.w + bb.w;
        ((float4*)xr)[lane + 64 * j] = v[j];
        uint2 o; o.x = f2bf(v[j].x) | (f2bf(v[j].y) << 16); o.y = f2bf(v[j].z) | (f2bf(v[j].w) << 16);
        ((uint2*)(p.x1b + (size_t)t * DM))[lane + 64 * j] = o; }
    float gl[4] = {0.f, 0.f, 0.f, 0.f};
#pragma unroll
    for (int j = 0; j < 4; ++j) { const int k = 4 * (lane + 64 * j);
        const float xv[4] = {v[j].x, v[j].y, v[j].z, v[j].w};
#pragma unroll
        for (int c = 0; c < 4; ++c) { const float4 w = *(const float4*)(p.wrg + (size_t)(k + c) * 4); gl[0] += xv[c] * w.x; gl[1] += xv[c] * w.y; gl[2] += xv[c] * w.z; gl[3] += xv[c] * w.w; } }
#pragma unroll
    for (int c = 0; c < 4; ++c) gl[c] = wave_sum(gl[c]) + p.brg[c];
    int gi = 0; float gm = gl[0];
#pragma unroll
    for (int c = 1; c < 4; ++c) if (gl[c] > gm) { gm = gl[c]; gi = c; }
    float gs = 0.f;
#pragma unroll
    for (int c = 0; c < 4; ++c) gs += __expf(gl[c] - gm);
    const float gw = 1.f / gs;
    float el[8] = {0.f, 0.f, 0.f, 0.f, 0.f, 0.f, 0.f, 0.f};
#pragma unroll
    for (int j = 0; j < 4; ++j) { const int k = 4 * (lane + 64 * j);
        const float xv[4] = {v[j].x, v[j].y, v[j].z, v[j].w};
#pragma unroll
        for (int c = 0; c < 4; ++c) { const float4 w0 = *(const float4*)(p.wre + (size_t)(k + c) * 32 + 8 * gi), w1 = *(const float4*)(p.wre + (size_t)(k + c) * 32 + 8 * gi + 4);
            el[0] += xv[c] * w0.x; el[1] += xv[c] * w0.y; el[2] += xv[c] * w0.z; el[3] += xv[c] * w0.w; el[4] += xv[c] * w1.x; el[5] += xv[c] * w1.y; el[6] += xv[c] * w1.z; el[7] += xv[c] * w1.w; } }
#pragma unroll
    for (int c = 0; c < 8; ++c) el[c] = wave_sum(el[c]) + p.bre[8 * gi + c];
    int i0 = 0; float m0 = el[0];
#pragma unroll
    for (int c = 1; c < 8; ++c) if (el[c] > m0) { m0 = el[c]; i0 = c; }
    int i1 = -1; float m1 = -INFINITY;
#pragma unroll
    for (int c = 0; c < 8; ++c) if (c != i0 && el[c] > m1) { m1 = el[c]; i1 = c; }
    const float ex1 = __expf(m1 - m0), w0 = gw / (1.f + ex1), w1 = gw * ex1 / (1.f + ex1);
    if (lane == 0) {
        const int e0 = 8 * gi + i0, e1 = 8 * gi + i1;
        const u32 p0 = atomicAdd(p.cnt + e0, 1u), p1 = atomicAdd(p.cnt + e1, 1u);
        p.lists[(size_t)e0 * T + p0] = t * 2; p.lists[(size_t)e1 * T + p1] = t * 2 + 1;
        u32* r = p.route + (size_t)t * 8; r[0] = e0; r[1] = e1; r[2] = __float_as_uint(w0); r[3] = __float_as_uint(w1); r[4] = p0; r[5] = p1;
    }
}

__global__ void __launch_bounds__(256) k_moe_naive(const bf16_t* __restrict__ x1b, const bf16_t* __restrict__ wgu_t, const bf16_t* __restrict__ wd_t, const u32* __restrict__ route, bf16_t* __restrict__ ybuf) {
    __shared__ float xs[DM]; __shared__ float act[DEXP];
    const int tid = threadIdx.x, t = blockIdx.x >> 1, k = blockIdx.x & 1;
    const int e = (int)route[(size_t)t * 8 + k]; const float w = __uint_as_float(route[(size_t)t * 8 + 2 + k]);
    for (int i = tid; i < DM; i += 256) xs[i] = bf2f(x1b[(size_t)t * DM + i]);
    __syncthreads();
    { const int j = tid; const bf16_t* gr = wgu_t + ((size_t)e * 512 + 256 * (j >> 7) + (j & 127)) * DM; const bf16_t* ur = gr + (size_t)128 * DM;
      float g = 0.f, u = 0.f;
      for (int c = 0; c < DM; c += 2) { const u32 a = *(const u32*)(gr + c), b2 = *(const u32*)(ur + c);
          g += xs[c] * bf2f((bf16_t)(a & 0xffff)) + xs[c + 1] * bf2f((bf16_t)(a >> 16)); u += xs[c] * bf2f((bf16_t)(b2 & 0xffff)) + xs[c + 1] * bf2f((bf16_t)(b2 >> 16)); }
      act[j] = bf2f((bf16_t)f2bf(g / (1.f + __expf(-g)) * u)); }
    __syncthreads();
    for (int c = tid; c < DM; c += 256) { const bf16_t* dr = wd_t + ((size_t)e * DM + c) * DEXP; float y = 0.f;
        for (int j = 0; j < DEXP; ++j) y += act[j] * bf2f(dr[j]);
        ybuf[((size_t)t * 2 + k) * DM + c] = (bf16_t)f2bf(y * w); }
}
__global__ void __launch_bounds__(256) k_final(float* __restrict__ out, const bf16_t* __restrict__ ybuf, const float* __restrict__ g2, const float* __restrict__ b2) {
    const int lane = threadIdx.x & 63, t = blockIdx.x * 4 + (threadIdx.x >> 6);
    float4 v[4]; float s = 0.f; float* xr = out + (size_t)t * DM;
#pragma unroll
    for (int j = 0; j < 4; ++j) { v[j] = ((const float4*)xr)[lane + 64 * j];
        const uint2 a = ((const uint2*)(ybuf + (size_t)t * 2 * DM))[lane + 64 * j], b = ((const uint2*)(ybuf + ((size_t)t * 2 + 1) * DM))[lane + 64 * j];
        v[j].x = ALPHA * v[j].x + bf2f((bf16_t)(a.x & 0xffff)) + bf2f((bf16_t)(b.x & 0xffff)); v[j].y = ALPHA * v[j].y + bf2f((bf16_t)(a.x >> 16)) + bf2f((bf16_t)(b.x >> 16));
        v[j].z = ALPHA * v[j].z + bf2f((bf16_t)(a.y & 0xffff)) + bf2f((bf16_t)(b.y & 0xffff)); v[j].w = ALPHA * v[j].w + bf2f((bf16_t)(a.y >> 16)) + bf2f((bf16_t)(b.y >> 16));
        s += (v[j].x + v[j].y) + (v[j].z + v[j].w); }
    const float mean = wave_sum(s) * (1.f / DM); float s2 = 0.f;
#pragma unroll
    for (int j = 0; j < 4; ++j) { v[j].x -= mean; v[j].y -= mean; v[j].z -= mean; v[j].w -= mean; s2 += (v[j].x * v[j].x + v[j].y * v[j].y) + (v[j].z * v[j].z + v[j].w * v[j].w); }
    const float rstd = rsqrtf(wave_sum(s2) * (1.f / DM) + LN_EPS);
#pragma unroll
    for (int j = 0; j < 4; ++j) { const float4 g = ((const float4*)g2)[lane + 64 * j], bb = ((const float4*)b2)[lane + 64 * j];
        float4 o; o.x = v[j].x * rstd * g.x + bb.x; o.y = v[j].y * rstd * g.y + bb.y; o.z = v[j].z * rstd * g.z + bb.z; o.w = v[j].w * rstd * g.w + bb.w;
        ((float4*)xr)[lane + 64 * j] = o; }
}

extern "C" void kernel_launch(void* const* d_in, const int* in_sizes, int n_in, void* d_out, int out_size, void* d_ws, size_t ws_size, hipStream_t stream) {
    if (n_in != 26 || out_size != T * DM || ws_size < WS_END) { fprintf(stderr, "kernel_launch: unexpected sizes n_in %d out %d ws %zu\n", n_in, out_size, ws_size); return; }
    const float* x = (const float*)d_in[0]; const float* mem = (const float*)d_in[1]; const float* w_in = (const float*)d_in[2];
    const float* b_forget = (const float*)d_in[3]; const float* b_gates = (const float*)d_in[4];
    const float* lq1 = (const float*)d_in[5]; const float* lk1 = (const float*)d_in[6]; const float* lq2 = (const float*)d_in[7]; const float* lk2 = (const float*)d_in[8];
    const float* subln_g = (const float*)d_in[9]; const float* w_mem_kv = (const float*)d_in[10];
    const float* w_br[3] = {(const float*)d_in[11], (const float*)d_in[12], (const float*)d_in[13]}; const float* w_out = (const float*)d_in[14];
    const float* ln1_g = (const float*)d_in[15]; const float* ln1_b = (const float*)d_in[16];
    const float* wrg = (const float*)d_in[17]; const float* brg = (const float*)d_in[18]; const float* wre = (const float*)d_in[19]; const float* bre = (const float*)d_in[20];
    const float* weg = (const float*)d_in[21]; const float* weu = (const float*)d_in[22]; const float* wed = (const float*)d_in[23];
    const float* ln2_g = (const float*)d_in[24]; const float* ln2_b = (const float*)d_in[25];
    unsigned char* ws = (unsigned char*)d_ws; unsigned char* dob = (unsigned char*)d_out; float* out = (float*)d_out;
    u32* ctl = (u32*)(ws + WS_CTL);
    bf16_t* xb = (bf16_t*)(dob + DO_XB); bf16_t* win_t = (bf16_t*)(dob + DO_WIN_T); bf16_t* memb = (bf16_t*)(dob + DO_MEMB); bf16_t* wmkv_t = (bf16_t*)(dob + DO_WMKV_T);
    bf16_t* wbr_t = (bf16_t*)(ws + WS_WBR_T); bf16_t* wout_t = (bf16_t*)(ws + WS_WOUT_T);
    float* fbias = (float*)(ws + WS_FBIAS); float* logf = (float*)(ws + WS_LOGF);
    bf16_t* memk = (bf16_t*)(ws + WS_MEMK); bf16_t* memvt = (bf16_t*)(ws + WS_MEMVT);
    bf16_t* qkv = (bf16_t*)(ws + WS_QKV); bf16_t* gates = (bf16_t*)(ws + WS_GATES); bf16_t* hb = (bf16_t*)(ws + WS_HB); bf16_t* dpart = (bf16_t*)(ws + WS_DPART);
    bf16_t* yfox = (bf16_t*)(dob + DO_YFOX); bf16_t* ymem = (bf16_t*)(dob + DO_YMEM); bf16_t* ydiff = (bf16_t*)(dob + DO_YDIFF);
    bf16_t* wgu_t = (bf16_t*)(ws + WS_WGU_T); bf16_t* wd_t = (bf16_t*)(ws + WS_WD_T); bf16_t* x1b = (bf16_t*)(ws + WS_X1B); bf16_t* ybuf = (bf16_t*)(ws + WS_YBUF);
    u32* route = (u32*)(ws + WS_ROUTE); int* lists = (int*)(ws + WS_LISTS);

    hipMemsetAsync(ws + WS_CTL, 0, CTL_ZERO_BYTES, stream);
    k_cvt<<<2048, 256, 0, stream>>>(x, xb, (size_t)T * DM / 4);
    k_cvt<<<512, 256, 0, stream>>>(mem, memb, (size_t)NB * NMEM * DM / 4);
    k_transpose_cvt<<<dim3(NPROJ / 32, DM / 32, 1), 256, 0, stream>>>(w_in, 0, DM, NPROJ, INCOLS, 0, win_t, 0, 0);
    k_transpose_cvt<<<dim3(1024 / 32, DM / 32, 1), 256, 0, stream>>>(w_mem_kv, 0, DM, 1024, 1024, 0, wmkv_t, 0, 0);
    for (int i = 0; i < 3; ++i) k_transpose_cvt<<<dim3(DM / 32, 512 / 32, 1), 256, 0, stream>>>(w_br[i], 0, 512, DM, DM, 0, wbr_t + (size_t)i * DM * 512, 0, 0);
    k_transpose_cvt<<<dim3(DM / 32, DM / 32, 1), 256, 0, stream>>>(w_out, 0, DM, DM, DM, 0, wout_t, 0, 0);
    k_forget<<<T / 4, 256, 0, stream>>>(x, w_in, b_forget, logf);
    k_cumsum<<<32, 64, 0, stream>>>(logf, fbias);
    { GemmP p{}; p.A = xb; p.Bt = win_t; p.M = T; p.N = NPROJ; p.K = DM; p.lda = DM; p.ldb = DM; p.o0 = qkv; p.o1 = gates;
      k_gemm_naive<MODE_PROJ><<<dim3(NPROJ / 64, T / 64), 256, 0, stream>>>(p); }
    { GemmP p{}; p.A = memb; p.Bt = wmkv_t; p.M = 1024; p.N = 512; p.K = DM; p.lda = DM; p.ldb = DM; p.o0 = memk;
      k_gemm_naive<MODE_BF16><<<dim3(512 / 64, 1024 / 64), 256, 0, stream>>>(p); }
    { GemmP p{}; p.A = wmkv_t + (size_t)512 * DM; p.Bt = memb; p.M = 512; p.N = 1024; p.K = DM; p.lda = DM; p.ldb = DM; p.o0 = memvt;
      k_gemm_naive<MODE_BF16><<<dim3(1024 / 64, 512 / 64), 256, 0, stream>>>(p); }
    { AttnP p{qkv, fbias, yfox, dpart}; k_attn_naive<<<dim3(T, 24), 64, 0, stream>>>(p); }
    k_memattn_naive<<<dim3(T, 4), 64, 0, stream>>>(qkv, memk, memvt, ymem);
    k_diff_combine<<<T, 256, 0, stream>>>(dpart, lq1, lk1, lq2, lk2, subln_g, ydiff);
    k_transpose_cvt<<<dim3(DEXP / 32, DM / 32, NEXP), 256, 0, stream>>>(weg, (size_t)DM * DEXP, DM, DEXP, DEXP, 0, wgu_t, (size_t)512 * DM, 1);
    k_transpose_cvt<<<dim3(DEXP / 32, DM / 32, NEXP), 256, 0, stream>>>(weu, (size_t)DM * DEXP, DM, DEXP, DEXP, 0, wgu_t, (size_t)512 * DM, 2);
    k_transpose_cvt<<<dim3(DM / 32, DEXP / 32, NEXP), 256, 0, stream>>>(wed, (size_t)DEXP * DM, DEXP, DM, DM, 0, wd_t, (size_t)DM * DEXP, 0);
    { const bf16_t* ys[3] = {yfox, ydiff, ymem};
      for (int i = 0; i < 3; ++i) { GemmP p{}; p.A = ys[i]; p.Bt = wbr_t + (size_t)i * DM * 512; p.M = T; p.N = DM; p.K = 512; p.lda = 512; p.ldb = 512; p.o0 = hb; p.g = gates; p.bias = b_gates; p.aux = i;
          k_gemm_naive<MODE_BRANCH><<<dim3(DM / 64, T / 64), 256, 0, stream>>>(p); } }
    { GemmP p{}; p.A = hb; p.Bt = wout_t; p.M = T; p.N = DM; p.K = DM; p.lda = DM; p.ldb = DM; p.xres = x; p.of = out;
      k_gemm_naive<MODE_OUT><<<dim3(DM / 64, T / 64), 256, 0, stream>>>(p); }
    { RouteP p{out, x1b, ln1_g, ln1_b, wrg, brg, wre, bre, ctl + CW_CNT, lists, route}; k_ln1_route<<<T / 4, 256, 0, stream>>>(p); }
    k_moe_naive<<<T * 2, 256, 0, stream>>>(x1b, wgu_t, wd_t, route, ybuf);
    k_final<<<T / 4, 256, 0, stream>>>(out, ybuf, ln2_g, ln2_b);
}
```

```cpp
#include <hip/hip_runtime.h>
#include <cstdio>
#include <cstdint>

typedef unsigned short bf16_t;
typedef unsigned int u32;

constexpr int T = 16384, DM = 1024, NB = 4, SEQ = 4096, NMEM = 256;
constexpr int NQKV = 3584, NGATE = 3072, NPROJ = 6656, INCOLS = 6664;
constexpr int NEXP = 32, DEXP = 256;
constexpr float LN_EPS = 1e-5f;
constexpr float LOG2E = 1.4426950408889634f;
constexpr float C2 = 0.125f * LOG2E;
constexpr float C2M = 0.08838834764831845f * LOG2E;
constexpr float ALPHA = 1.189207115002721f;
constexpr float LAM_INIT = 0.2f;
constexpr int C_FQ = 0, C_FK = 512, C_FV = 1024, C_DQ = 1536, C_DK = 2048, C_DV = 2560, C_MQ = 3072;

constexpr size_t MiB = 1u << 20;
constexpr size_t WS_CTL = 0, CTL_ZERO_BYTES = 1 * MiB;
constexpr size_t WS_WBR_T = 1 * MiB;
constexpr size_t WS_WOUT_T = 4 * MiB;
constexpr size_t WS_FBIAS = 6 * MiB;
constexpr size_t WS_LOGF = 6 * MiB + 512 * 1024;
constexpr size_t WS_MEMK = 7 * MiB;
constexpr size_t WS_MEMVT = 8 * MiB;
constexpr size_t WS_ROUTE = 9 * MiB;
constexpr size_t WS_LISTS = 10 * MiB;
constexpr size_t WS_QKV = 16 * MiB;
constexpr size_t WS_GATES = 128 * MiB;
constexpr size_t WS_HB = 224 * MiB;
constexpr size_t WS_DPART = 224 * MiB;
constexpr size_t WS_WGU_T = 16 * MiB;
constexpr size_t WS_WD_T = 48 * MiB;
constexpr size_t WS_X1B = 64 * MiB;
constexpr size_t WS_ACT = 96 * MiB;
constexpr size_t WS_YBUF = 128 * MiB;
constexpr size_t WS_END = 256 * MiB;
constexpr size_t DO_XB = 0;
constexpr size_t DO_WIN_T = 32 * MiB;
constexpr size_t DO_MEMB = 45 * MiB;
constexpr size_t DO_WMKV_T = 47 * MiB;
constexpr size_t DO_YFOX = 0;
constexpr size_t DO_YMEM = 16 * MiB;
constexpr size_t DO_YDIFF = 32 * MiB;
constexpr int CW_CNT = 1024;

__device__ __forceinline__ u32 f2bf(float f) { u32 u = __builtin_bit_cast(u32, f); return (u + 0x7fffu + ((u >> 16) & 1u)) >> 16; }
__device__ __forceinline__ float bf2f(bf16_t b) { return __builtin_bit_cast(float, (u32)b << 16); }
__device__ __forceinline__ float wave_sum(float v) {
#pragma unroll
    for (int o = 1; o < 64; o <<= 1) v += __shfl_xor(v, o);
    return v;
}
__device__ __forceinline__ float wave_max(float v) {
#pragma unroll
    for (int o = 1; o < 64; o <<= 1) v = fmaxf(v, __shfl_xor(v, o));
    return v;
}
__device__ __forceinline__ float lam_value(const float* q1, const float* k1, const float* q2, const float* k2) {
    float s1 = 0.f, s2 = 0.f;
    for (int i = 0; i < 64; ++i) { s1 += q1[i] * k1[i]; s2 += q2[i] * k2[i]; }
    return __expf(s1) - __expf(s2) + LAM_INIT;
}

__global__ void k_cvt(const float* __restrict__ src, bf16_t* __restrict__ dst, size_t n4) {
    for (size_t i = (size_t)blockIdx.x * blockDim.x + threadIdx.x; i < n4; i += (size_t)gridDim.x * blockDim.x) {
        const float4 v = ((const float4*)src)[i];
        uint2 o; o.x = f2bf(v.x) | (f2bf(v.y) << 16); o.y = f2bf(v.z) | (f2bf(v.w) << 16);
        ((uint2*)dst)[i] = o;
    }
}
__global__ void k_transpose_cvt(const float* __restrict__ W, size_t wbatch, int K, int N, int ldw, int col0, bf16_t* __restrict__ Wt, size_t tbatch, int mode) {
    __shared__ float tile[32][33];
    const float* Wb = W + wbatch * blockIdx.z; bf16_t* Tb = Wt + tbatch * blockIdx.z;
    const int n0 = blockIdx.x * 32, k0 = blockIdx.y * 32, tx = threadIdx.x & 31, ty = threadIdx.x >> 5;
    for (int i = ty; i < 32; i += 8) tile[i][tx] = Wb[(size_t)(k0 + i) * ldw + col0 + n0 + tx];
    __syncthreads();
    for (int i = ty; i < 32; i += 8) {
        const int n = n0 + i; int r = n;
        if (mode == 1) r = 256 * (n >> 7) + (n & 127);
        if (mode == 2) r = 256 * (n >> 7) + 128 + (n & 127);
        Tb[(size_t)r * K + k0 + tx] = (bf16_t)f2bf(tile[tx][i]);
    }
}
__global__ void k_forget(const float* __restrict__ x, const float* __restrict__ w_in, const float* __restrict__ b_forget, float* __restrict__ logf) {
    const int lane = threadIdx.x & 63, t = blockIdx.x * (blockDim.x >> 6) + (threadIdx.x >> 6);
    if (t >= T) return;
    float a[8];
#pragma unroll
    for (int h = 0; h < 8; ++h) a[h] = 0.f;
    for (int i = 0; i < 16; ++i) {
        const int k = lane + 64 * i; const float xv = x[(size_t)t * DM + k];
        const float4 w0 = *(const float4*)(w_in + (size_t)k * INCOLS + NPROJ), w1 = *(const float4*)(w_in + (size_t)k * INCOLS + NPROJ + 4);
        a[0] += xv * w0.x; a[1] += xv * w0.y; a[2] += xv * w0.z; a[3] += xv * w0.w; a[4] += xv * w1.x; a[5] += xv * w1.y; a[6] += xv * w1.z; a[7] += xv * w1.w;
    }
#pragma unroll
    for (int h = 0; h < 8; ++h) a[h] = wave_sum(a[h]);
    if (lane < 8) {
        float z = 0.f;
#pragma unroll
        for (int h = 0; h < 8; ++h) if (lane == h) z = a[h];
        z += b_forget[lane];
        logf[(size_t)t * 8 + lane] = fminf(z, 0.f) - log1pf(__expf(-fabsf(z)));
    }
}
__global__ void k_cumsum(const float* __restrict__ logf, float* __restrict__ fbias) {
    const int lane = threadIdx.x, bh = blockIdx.x, b = bh >> 3, h = bh & 7;
    float loc = 0.f;
    for (int i = 0; i < 64; ++i) loc += logf[((size_t)b * SEQ + lane * 64 + i) * 8 + h];
    float inc = loc;
#pragma unroll
    for (int o = 1; o < 64; o <<= 1) { const float v = __shfl_up(inc, o); if (lane >= o) inc += v; }
    float run = inc - loc;
    for (int i = 0; i < 64; ++i) { run += logf[((size_t)b * SEQ + lane * 64 + i) * 8 + h]; fbias[(size_t)bh * SEQ + lane * 64 + i] = -run * LOG2E; }
}

struct GemmP {
    const bf16_t* A; const bf16_t* Bt; int M, N, K, lda, ldb;
    bf16_t* o0; bf16_t* o1; const bf16_t* g; const float* bias; const float* xres; float* of; int aux;
};
enum { MODE_PROJ = 0, MODE_BF16 = 1, MODE_BRANCH = 2, MODE_OUT = 3 };
template <int MODE> __device__ __forceinline__ void gemm_epi(const GemmP& p, int m, int n, float acc) {
    if (MODE == MODE_PROJ) {
        if (n < NQKV) { float sc = 1.f; if (n < 512 || (n >= C_DQ && n < C_DK)) sc = C2; else if (n >= C_MQ) sc = C2M; p.o0[(size_t)m * NQKV + n] = (bf16_t)f2bf(acc * sc); }
        else p.o1[(size_t)m * NGATE + (n - NQKV)] = (bf16_t)f2bf(acc);
    } else if (MODE == MODE_BF16) {
        p.o0[(size_t)m * p.N + n] = (bf16_t)f2bf(acc);
    } else if (MODE == MODE_BRANCH) {
        const int i = p.aux; const float gl = bf2f(p.g[(size_t)m * NGATE + i * DM + n]) + p.bias[i * DM + n];
        const float v = acc / (1.f + __expf(-gl));
        bf16_t* hp = p.o0 + (size_t)m * DM + n;
        *hp = (bf16_t)f2bf(i == 0 ? v : bf2f(*hp) + v);
    } else if (MODE == MODE_OUT) {
        p.of[(size_t)m * DM + n] = ALPHA * p.xres[(size_t)m * DM + n] + acc;
    }
}
template <int MODE> __global__ void __launch_bounds__(256) k_gemm_naive(GemmP p) {
    __shared__ float As[16][65], Bs[16][65];
    const int m0 = blockIdx.y * 64, n0 = blockIdx.x * 64, tid = threadIdx.x, tx = tid & 15, ty = tid >> 4;
    float acc[4][4];
#pragma unroll
    for (int i = 0; i < 4; ++i)
#pragma unroll
        for (int j = 0; j < 4; ++j) acc[i][j] = 0.f;
    const int lr = tid >> 2, lc = (tid & 3) * 4;
    for (int k0 = 0; k0 < p.K; k0 += 16) {
        const uint2 av = *(const uint2*)(p.A + (size_t)(m0 + lr) * p.lda + k0 + lc);
        const uint2 bv = *(const uint2*)(p.Bt + (size_t)(n0 + lr) * p.ldb + k0 + lc);
        As[lc + 0][lr] = bf2f((bf16_t)(av.x & 0xffff)); As[lc + 1][lr] = bf2f((bf16_t)(av.x >> 16)); As[lc + 2][lr] = bf2f((bf16_t)(av.y & 0xffff)); As[lc + 3][lr] = bf2f((bf16_t)(av.y >> 16));
        Bs[lc + 0][lr] = bf2f((bf16_t)(bv.x & 0xffff)); Bs[lc + 1][lr] = bf2f((bf16_t)(bv.x >> 16)); Bs[lc + 2][lr] = bf2f((bf16_t)(bv.y & 0xffff)); Bs[lc + 3][lr] = bf2f((bf16_t)(bv.y >> 16));
        __syncthreads();
#pragma unroll
        for (int kk = 0; kk < 16; ++kk) {
            float a[4], b[4];
#pragma unroll
            for (int i = 0; i < 4; ++i) { a[i] = As[kk][ty * 4 + i]; b[i] = Bs[kk][tx * 4 + i]; }
#pragma unroll
            for (int i = 0; i < 4; ++i)
#pragma unroll
                for (int j = 0; j < 4; ++j) acc[i][j] += a[i] * b[j];
        }
        __syncthreads();
    }
#pragma unroll
    for (int i = 0; i < 4; ++i)
#pragma unroll
        for (int j = 0; j < 4; ++j) gemm_epi<MODE>(p, m0 + ty * 4 + i, n0 + tx * 4 + j, acc[i][j]);
}

struct AttnP { const bf16_t* qkv; const float* fbias; bf16_t* yfox; bf16_t* dpart; };
__global__ void __launch_bounds__(64) k_attn_naive(AttnP p) {
    __shared__ float lg[SEQ]; __shared__ float qs[64];
    const int lane = threadIdx.x, t = blockIdx.x, he = blockIdx.y, b = t / SEQ, qpos = t % SEQ;
    int qcol, kcol, vcol; const float* brow = nullptr; float slope2 = 0.f; bf16_t* outp;
    if (he < 8) { qcol = C_FQ + 64 * he; kcol = C_FK + 64 * he; vcol = C_FV + 64 * he; brow = p.fbias + (size_t)(b * 8 + he) * SEQ; outp = p.yfox + (size_t)t * 512 + 64 * he; }
    else { const int e = he - 8, h = e >> 2, i = (e >> 1) & 1, j = e & 1; qcol = C_DQ + 128 * h + 64 * i; kcol = C_DK + 128 * h + 64 * i; vcol = C_DV + 128 * h + 64 * j;
           slope2 = exp2f(-2.f * (h + 1)) * LOG2E; outp = p.dpart + (size_t)t * 1024 + e * 64; }
    qs[lane] = bf2f(p.qkv[(size_t)t * NQKV + qcol + lane]);
    __syncthreads();
    const bf16_t* kb = p.qkv + (size_t)b * SEQ * NQKV + kcol; const bf16_t* vb = p.qkv + (size_t)b * SEQ * NQKV + vcol;
    float mx = -INFINITY;
    for (int s0 = 0; s0 <= qpos; s0 += 64) {
        const int s = s0 + lane; float d = -INFINITY;
        if (s <= qpos) { d = 0.f; const bf16_t* kr = kb + (size_t)s * NQKV;
            for (int c = 0; c < 64; c += 2) { const u32 w = *(const u32*)(kr + c); d += qs[c] * bf2f((bf16_t)(w & 0xffff)) + qs[c + 1] * bf2f((bf16_t)(w >> 16)); }
            d += brow ? brow[s] : slope2 * (float)(s - qpos); }
        lg[s] = d; mx = fmaxf(mx, d);
    }
    mx = wave_max(mx);
    float l = 0.f;
    const int nk = ((qpos >> 6) + 1) << 6;
    for (int s = lane; s < nk; s += 64) { const float pv = exp2f(lg[s] - mx); lg[s] = pv; l += pv; }
    l = wave_sum(l);
    __syncthreads();
    float o = 0.f;
    for (int s = 0; s <= qpos; ++s) o += lg[s] * bf2f(vb[(size_t)s * NQKV + lane]);
    outp[lane] = (bf16_t)f2bf(o / l);
}
__global__ void __launch_bounds__(64) k_memattn_naive(const bf16_t* __restrict__ qkv, const bf16_t* __restrict__ memk, const bf16_t* __restrict__ memvt, bf16_t* __restrict__ ymem) {
    __shared__ float qs[128]; __shared__ float pr[256];
    const int lane = threadIdx.x, t = blockIdx.x, h = blockIdx.y, b = t / SEQ;
    qs[lane] = bf2f(qkv[(size_t)t * NQKV + C_MQ + 128 * h + lane]); qs[lane + 64] = bf2f(qkv[(size_t)t * NQKV + C_MQ + 128 * h + 64 + lane]);
    __syncthreads();
    float lgv[4]; float mx = -INFINITY;
#pragma unroll
    for (int i = 0; i < 4; ++i) { const int m = lane + 64 * i; const bf16_t* kr = memk + (size_t)(b * 256 + m) * 512 + 128 * h; float d = 0.f;
        for (int c = 0; c < 128; ++c) d += qs[c] * bf2f(kr[c]);
        lgv[i] = d; mx = fmaxf(mx, d); }
    mx = wave_max(mx); float l = 0.f;
#pragma unroll
    for (int i = 0; i < 4; ++i) { const float pv = exp2f(lgv[i] - mx); pr[lane + 64 * i] = pv; l += pv; }
    l = wave_sum(l);
    __syncthreads();
#pragma unroll
    for (int i = 0; i < 2; ++i) { const int d = lane + 64 * i; const bf16_t* vr = memvt + (size_t)(128 * h + d) * 1024 + b * 256; float o = 0.f;
        for (int m = 0; m < 256; ++m) o += pr[m] * bf2f(vr[m]);
        ymem[(size_t)t * 512 + 128 * h + d] = (bf16_t)f2bf(o / l); }
}
__global__ void __launch_bounds__(256) k_diff_combine(const bf16_t* __restrict__ dpart, const float* q1, const float* k1, const float* q2, const float* k2, const float* __restrict__ g, bf16_t* __restrict__ ydiff) {
    const int lane = threadIdx.x & 63, w = blockIdx.x * 4 + (threadIdx.x >> 6), t = w >> 2, h = w & 3;
    const float lam = lam_value(q1, k1, q2, k2);
    const bf16_t* pp = dpart + (size_t)t * 1024 + h * 256;
    float v[2]; float ss = 0.f;
#pragma unroll
    for (int j = 0; j < 2; ++j) { v[j] = bf2f(pp[j * 64 + lane]) - lam * bf2f(pp[128 + j * 64 + lane]); ss += v[j] * v[j]; }
    ss = wave_sum(ss); const float r = rsqrtf(ss * (1.f / 128.f) + LN_EPS) * (1.f - LAM_INIT);
#pragma unroll
    for (int j = 0; j < 2; ++j) ydiff[(size_t)t * 512 + h * 128 + j * 64 + lane] = (bf16_t)f2bf(v[j] * r * g[j * 64 + lane]);
}

struct RouteP { float* x1; bf16_t* x1b; const float* g1; const float* b1; const float* wrg; const float* brg; const float* wre; const float* bre; u32* cnt; int* lists; u32* route; };
__global__ void __launch_bounds__(256) k_ln1_route(RouteP p) {
    const int lane = threadIdx.x & 63, t = blockIdx.x * 4 + (threadIdx.x >> 6);
    float4 v[4]; float s = 0.f;
    float* xr = p.x1 + (size_t)t * DM;
#pragma unroll
    for (int j = 0; j < 4; ++j) { v[j] = ((const float4*)xr)[lane + 64 * j]; s += (v[j].x + v[j].y) + (v[j].z + v[j].w); }
    const float mean = wave_sum(s) * (1.f / DM); float s2 = 0.f;
#pragma unroll
    for (int j = 0; j < 4; ++j) { v[j].x -= mean; v[j].y -= mean; v[j].z -= mean; v[j].w -= mean; s2 += (v[j].x * v[j].x + v[j].y * v[j].y) + (v[j].z * v[j].z + v[j].w * v[j].w); }
    const float rstd = rsqrtf(wave_sum(s2) * (1.f / DM) + LN_EPS);
#pragma unroll
    for (int j = 0; j < 4; ++j) { const float4 g = ((const float4*)p.g1)[lane + 64 * j], bb = ((const float4*)p.b1)[lane + 64 * j];
        v[j].x = v[j].x * rstd * g.x + bb.x; v[j].y = v[j].y * rstd * g.y + bb.y; v[j].z = v[j].z * rstd * g.z + bb.z; v[j].w = v[j].w * rstd * g.w + bb.w;
        ((float4*)xr)[lane + 64 * j] = v[j];
        uint2 o; o.x = f2bf(v[j].x) | (f2bf(v[j].y) << 16); o.y = f2bf(v[j].z) | (f2bf(v[j].w) << 16);
        ((uint2*)(p.x1b + (size_t)t * DM))[lane + 64 * j] = o; }
    float gl[4] = {0.f, 0.f, 0.f, 0.f};
#pragma unroll
    for (int j = 0; j < 4; ++j) { const int k = 4 * (lane + 64 * j);
        const float xv[4] = {v[j].x, v[j].y, v[j].z, v[j].w};
#pragma unroll
        for (int c = 0; c < 4; ++c) { const float4 w = *(const float4*)(p.wrg + (size_t)(k + c) * 4); gl[0] += xv[c] * w.x; gl[1] += xv[c] * w.y; gl[2] += xv[c] * w.z; gl[3] += xv[c] * w.w; } }
#pragma unroll
    for (int c = 0; c < 4; ++c) gl[c] = wave_sum(gl[c]) + p.brg[c];
    int gi = 0; float gm = gl[0];
#pragma unroll
    for (int c = 1; c < 4; ++c) if (gl[c] > gm) { gm = gl[c]; gi = c; }
    float gs = 0.f;
#pragma unroll
    for (int c = 0; c < 4; ++c) gs += __expf(gl[c] - gm);
    const float gw = 1.f / gs;
    float el[8] = {0.f, 0.f, 0.f, 0.f, 0.f, 0.f, 0.f, 0.f};
#pragma unroll
    for (int j = 0; j < 4; ++j) { const int k = 4 * (lane + 64 * j);
        const float xv[4] = {v[j].x, v[j].y, v[j].z, v[j].w};
#pragma unroll
        for (int c = 0; c < 4; ++c) { const float4 w0 = *(const float4*)(p.wre + (size_t)(k + c) * 32 + 8 * gi), w1 = *(const float4*)(p.wre + (size_t)(k + c) * 32 + 8 * gi + 4);
            el[0] += xv[c] * w0.x; el[1] += xv[c] * w0.y; el[2] += xv[c] * w0.z; el[3] += xv[c] * w0.w; el[4] += xv[c] * w1.x; el[5] += xv[c] * w1.y; el[6] += xv[c] * w1.z; el[7] += xv[c] * w1.w; } }
#pragma unroll
    for (int c = 0; c < 8; ++c) el[c] = wave_sum(el[c]) + p.bre[8 * gi + c];
    int i0 = 0; float m0 = el[0];
#pragma unroll
    for (int c = 1; c < 8; ++c) if (el[c] > m0) { m0 = el[c]; i0 = c; }
    int i1 = -1; float m1 = -INFINITY;
#pragma unroll
    for (int c = 0; c < 8; ++c) if (c != i0 && el[c] > m1) { m1 = el[c]; i1 = c; }
    const float ex1 = __expf(m1 - m0), w0 = gw / (1.f + ex1), w1 = gw * ex1 / (1.f + ex1);
    if (lane == 0) {
        const int e0 = 8 * gi + i0, e1 = 8 * gi + i1;
        const u32 p0 = atomicAdd(p.cnt + e0, 1u), p1 = atomicAdd(p.cnt + e1, 1u);
        p.lists[(size_t)e0 * T + p0] = t * 2; p.lists[(size_t)e1 * T + p1] = t * 2 + 1;
        u32* r = p.route + (size_t)t * 8; r[0] = e0; r[1] = e1; r[2] = __float_as_uint(w0); r[3] = __float_as_uint(w1); r[4] = p0; r[5] = p1;
    }
}

__global__ void __launch_bounds__(256) k_moe_naive(const bf16_t* __restrict__ x1b, const bf16_t* __restrict__ wgu_t, const bf16_t* __restrict__ wd_t, const u32* __restrict__ route, bf16_t* __restrict__ ybuf) {
    __shared__ float xs[DM]; __shared__ float act[DEXP];
    const int tid = threadIdx.x, t = blockIdx.x >> 1, k = blockIdx.x & 1;
    const int e = (int)route[(size_t)t * 8 + k]; const float w = __uint_as_float(route[(size_t)t * 8 + 2 + k]);
    for (int i = tid; i < DM; i += 256) xs[i] = bf2f(x1b[(size_t)t * DM + i]);
    __syncthreads();
    { const int j = tid; const bf16_t* gr = wgu_t + ((size_t)e * 512 + 256 * (j >> 7) + (j & 127)) * DM; const bf16_t* ur = gr + (size_t)128 * DM;
      float g = 0.f, u = 0.f;
      for (int c = 0; c < DM; c += 2) { const u32 a = *(const u32*)(gr + c), b2 = *(const u32*)(ur + c);
          g += xs[c] * bf2f((bf16_t)(a & 0xffff)) + xs[c + 1] * bf2f((bf16_t)(a >> 16)); u += xs[c] * bf2f((bf16_t)(b2 & 0xffff)) + xs[c + 1] * bf2f((bf16_t)(b2 >> 16)); }
      act[j] = bf2f((bf16_t)f2bf(g / (1.f + __expf(-g)) * u)); }
    __syncthreads();
    for (int c = tid; c < DM; c += 256) { const bf16_t* dr = wd_t + ((size_t)e * DM + c) * DEXP; float y = 0.f;
        for (int j = 0; j < DEXP; ++j) y += act[j] * bf2f(dr[j]);
        ybuf[((size_t)t * 2 + k) * DM + c] = (bf16_t)f2bf(y * w); }
}
__global__ void __launch_bounds__(256) k_final(float* __restrict__ out, const bf16_t* __restrict__ ybuf, const float* __restrict__ g2, const float* __restrict__ b2) {
    const int lane = threadIdx.x & 63, t = blockIdx.x * 4 + (threadIdx.x >> 6);
    float4 v[4]; float s = 0.f; float* xr = out + (size_t)t * DM;
#pragma unroll
    for (int j = 0; j < 4; ++j) { v[j] = ((const float4*)xr)[lane + 64 * j];
        const uint2 a = ((const uint2*)(ybuf + (size_t)t * 2 * DM))[lane + 64 * j], b = ((const uint2*)(ybuf + ((size_t)t * 2 + 1) * DM))[lane + 64 * j];
        v[j].x = ALPHA * v[j].x + bf2f((bf16_t)(a.x & 0xffff)) + bf2f((bf16_t)(b.x & 0xffff)); v[j].y = ALPHA * v[j].y + bf2f((bf16_t)(a.x >> 16)) + bf2f((bf16_t)(b.x >> 16));
        v[j].z = ALPHA * v[j].z + bf2f((bf16_t)(a.y & 0xffff)) + bf2f((bf16_t)(b.y & 0xffff)); v[j].w = ALPHA * v[j].w + bf2f((bf16_t)(a.y >> 16)) + bf2f((bf16_t)(b.y >> 16));
        s += (v[j].x + v[j].y) + (v[j].z + v[j].w); }
    const float mean = wave_sum(s) * (1.f / DM); float s2 = 0.f;
#pragma unroll
    for (int j = 0; j < 4; ++j) { v[j].x -= mean; v[j].y -= mean; v[j].z -= mean; v[j].w -= mean; s2 += (v[j].x * v[j].x + v[j].y * v[j].y) + (v[j].z * v[j].z + v[j].w * v[j].w); }
    const float rstd = rsqrtf(wave_sum(s2) * (1.f / DM) + LN_EPS);
#pragma unroll
    for (int j = 0; j < 4; ++j) { const float4 g = ((const float4*)g2)[lane + 64 * j], bb = ((const float4*)b2)[lane + 64 * j];
        float4 o; o.x = v[j].x * rstd * g.x + bb.x; o.y = v[j].y * rstd * g.y + bb.y; o.z = v[j].z * rstd * g.z + bb.z; o.w = v[j].w * rstd * g.w + bb.w;
        ((float4*)xr)[lane + 64 * j] = o; }
}


namespace pg8 {
#define PG8_LAS __attribute__((address_space(3)))
typedef unsigned short bf16_t;
typedef short bf16x8 __attribute__((ext_vector_type(8)));
typedef float f32x4 __attribute__((ext_vector_type(4)));
typedef unsigned u32x4 __attribute__((ext_vector_type(4)));
constexpr int BM = 256, BK = 64, HALF = 128, HTB = HALF * BK * 2  , STAGE_BYTES = 8 * HTB, NXCD = 8, WGM = 8;

__host__ __device__ __forceinline__ int lds_byte(int r, int c) { const int st = (r >> 4) * 2 + (c >> 5), rr = r & 15, cc = c & 31, ob = rr * 64 + cc * 2; return st * 1024 + (ob ^ (((ob >> 9) & 1) << 5)); }
__host__ __device__ __forceinline__ void stage_rc(int b, int& R, int& C) { const int st = b / 1024, sb = b % 1024, swz = sb ^ (((sb >> 9) & 1) << 5); R = (st >> 1) * 16 + swz / 64; C = (st & 1) * 32 + (swz % 64) / 2; }
__host__ __device__ __forceinline__ int perm32(int rho) { const int n = rho >> 4, i = rho & 15; return 8 * (i >> 2) + 4 * n + (i & 3); }

struct Unit { int pm, pn; };
struct Gemm { const bf16_t* A; const bf16_t* Bt; int M, N, K; };

struct StaticOrder {
    int nM, nN, nwg, G, c;
    __host__ __device__ void init(int M, int N, int G_, int c_) { nM = M / BM; nN = N / BM; nwg = nM * nN; G = G_; c = c_; }
    __host__ __device__ bool next(int i, Unit& u) const {
        const long L = (long)i * G + c; if (L >= nwg) return false;
        int wgid = (int)L; { const int q = nwg / NXCD, r = nwg % NXCD, xcd = wgid % NXCD, off = wgid / NXCD; wgid = (xcd < r ? xcd * (q + 1) : r * (q + 1) + (xcd - r) * q) + off; }
        const int nig = WGM * nN, gid = wgid / nig, fm = gid * WGM, gsz = (nM - fm) < WGM ? (nM - fm) : WGM;
        u.pm = fm + ((wgid % nig) % gsz); u.pn = (wgid % nig) / gsz; return true;
    }
    __device__ __forceinline__ void a_ready(const Unit&) const {}
    __device__ __forceinline__ void done(const Unit&) const {}
};

__device__ __forceinline__ unsigned cvt_pk_bf16(float lo, float hi) { unsigned r; asm volatile("v_cvt_pk_bf16_f32 %0, %1, %2" : "=v"(r) : "v"(lo), "v"(hi)); return r; }
typedef float f32x2 __attribute__((ext_vector_type(2)));
__device__ __forceinline__ f32x2 gelu_pk(f32x2 v) {
    const f32x2 av = __builtin_elementwise_abs(v), d = av * 0.2316418882f + 1.0f;
    f32x2 t; t.x = __builtin_amdgcn_rcpf(d.x); t.y = __builtin_amdgcn_rcpf(d.y);
    f32x2 q = t * 0.5307027145f + (-0.7265760135f); q = q * t + 0.7107068705f; q = q * t + (-0.142248368f); q = q * t + 0.127414796f; q = q * t;
    const f32x2 s = (v * v) * (-0.72134752044f);
    f32x2 e; e.x = __builtin_amdgcn_exp2f(s.x); e.y = __builtin_amdgcn_exp2f(s.y);
    const f32x2 m = v * (q * e), r = v - m;
    f32x2 o; o.x = v.x < 0.f ? m.x : r.x; o.y = v.y < 0.f ? m.y : r.y; return o;
}

template <int ACT  > struct EpiBf16 {
    static constexpr bool PERM = true, AFTER_DRAIN = false; static_assert(ACT == 0 || ACT == 1, "EpiBf16: ACT is 0 (none) or 1 (gelu_pk)");
    bf16_t* O; int ldc; const float* bias; int split_cols; size_t split_stride; float scale0;
    __device__ __forceinline__ void operator()(const f32x4 (&acc)[2][2][4][2], const Unit& u, int wr, int wc, int fr, int fq) const {
        const int row0 = u.pm * BM + wr * 64 + fr; int colt = u.pn * BM; bf16_t* base = O;
        float sc = 1.f; if (split_cols) { const int t = colt / split_cols; base += (size_t)t * split_stride; colt -= t * split_cols; if (t == 0) sc = scale0; }
        const int col0 = colt + wc * 32 + 8 * fq, bcol0 = u.pn * BM + wc * 32 + 8 * fq;
        f32x4 bv[2][2];
#pragma unroll
        for (int bj = 0; bj < 2; ++bj)
#pragma unroll
            for (int n = 0; n < 2; ++n) bv[bj][n] = bias ? *(const f32x4*)(bias + bcol0 + bj * HALF + 4 * n) : (f32x4){0.f, 0.f, 0.f, 0.f};
#pragma unroll
        for (int ai = 0; ai < 2; ++ai)
#pragma unroll
            for (int m = 0; m < 4; ++m) { bf16_t* rowp = base + (size_t)(row0 + ai * HALF + m * 16) * ldc + col0;
#pragma unroll
                for (int bj = 0; bj < 2; ++bj) { f32x4 v0 = acc[ai][bj][m][0] + bv[bj][0], v1 = acc[ai][bj][m][1] + bv[bj][1];
                    if (ACT == 1) { f32x2 a = gelu_pk((f32x2){v0[0], v0[1]}), b = gelu_pk((f32x2){v0[2], v0[3]}), c = gelu_pk((f32x2){v1[0], v1[1]}), d = gelu_pk((f32x2){v1[2], v1[3]});
                        v0 = (f32x4){a.x, a.y, b.x, b.y}; v1 = (f32x4){c.x, c.y, d.x, d.y}; }
                    v0 = v0 * sc; v1 = v1 * sc; u32x4 w; w.x = cvt_pk_bf16(v0[0], v0[1]); w.y = cvt_pk_bf16(v0[2], v0[3]); w.z = cvt_pk_bf16(v1[0], v1[1]); w.w = cvt_pk_bf16(v1[2], v1[3]);
                    *(u32x4*)(rowp + bj * HALF) = w; } }
    }
};

struct PanelStats {
    unsigned* xbuf;
    unsigned* cnt;
    unsigned* tmo;
    int ntn; float eps;
    unsigned code;
    __device__ __forceinline__ bool run(const f32x4 (&v)[2][2][4][2], const Unit& u, int wr, int wc, int fr, int fq, PG8_LAS unsigned char* lds, int wid, int lane) const {
        typedef float f32x2v __attribute__((ext_vector_type(2)));
        PG8_LAS f32x2v* P = (PG8_LAS f32x2v*)lds;
        PG8_LAS f32x2v* S = (PG8_LAS f32x2v*)(lds + 8192);
        PG8_LAS unsigned* flag = (PG8_LAS unsigned*)(lds + 8192 + 2048);
#pragma unroll
        for (int ai = 0; ai < 2; ++ai)
#pragma unroll
            for (int m = 0; m < 4; ++m) {
                float s = 0.f;
#pragma unroll
                for (int bj = 0; bj < 2; ++bj)
#pragma unroll
                    for (int n = 0; n < 2; ++n) { const f32x4 x = v[ai][bj][m][n]; s += (x[0] + x[1]) + (x[2] + x[3]); }
                s += __shfl_xor(s, 16); s += __shfl_xor(s, 32);
                const float mw = s * (1.0f / 64.0f); float q = 0.f;
#pragma unroll
                for (int bj = 0; bj < 2; ++bj)
#pragma unroll
                    for (int n = 0; n < 2; ++n) { const f32x4 d = v[ai][bj][m][n] - mw; q += (d[0] * d[0] + d[1] * d[1]) + (d[2] * d[2] + d[3] * d[3]); }
                q += __shfl_xor(q, 16); q += __shfl_xor(q, 32);
                if (fq == 0) P[(ai * HALF + wr * 64 + m * 16 + fr) * 4 + wc] = (f32x2v){mw, q};
            }
        asm volatile("s_waitcnt lgkmcnt(0)" ::: "memory"); __builtin_amdgcn_s_barrier(); asm volatile("" ::: "memory");
#if defined(BROKEN_EXCHANGE_NO_WAIT)
#warning BROKEN CONTROL BUILD: the row-statistics exchange does not wait; results are wrong by design
        if (blockIdx.x >= 64) { const long long t0_ = clock64(); while (clock64() - t0_ < 60000) __builtin_amdgcn_s_sleep(8); }
#endif
        const int row = wid * 32 + (lane & 31);
        if (lane < 32) {
            const f32x2v a = P[row * 4 + 0], b = P[row * 4 + 1], c = P[row * 4 + 2], d = P[row * 4 + 3];
            const float mt = (a.x + b.x + c.x + d.x) * 0.25f;
            const float da = a.x - mt, db = b.x - mt, dc = c.x - mt, dd = d.x - mt;
            const float m2 = (a.y + b.y) + (c.y + d.y) + 64.0f * ((da * da + db * db) + (dc * dc + dd * dd));
            unsigned long long* slot = (unsigned long long*)xbuf + ((size_t)(u.pm * BM + row) * 4 + u.pn);
            __hip_atomic_store(slot, ((unsigned long long)__float_as_uint(m2) << 32) | __float_as_uint(mt), __ATOMIC_RELAXED, __HIP_MEMORY_SCOPE_AGENT);
        }
        asm volatile("s_waitcnt vmcnt(0)" ::: "memory");
        if (lane == 0) __hip_atomic_fetch_add(cnt + 64 * u.pm, 1u, __ATOMIC_RELAXED, __HIP_MEMORY_SCOPE_AGENT);
        if (wid == 0) {
            bool dead = false; const unsigned long long t0 = __builtin_amdgcn_s_memrealtime(); const unsigned want = 8u * (unsigned)ntn;
            for (;;) {
#if defined(BROKEN_EXCHANGE_NO_WAIT)
                break;
#endif
                if ((unsigned)__builtin_amdgcn_readfirstlane(__hip_atomic_load(cnt + 64 * u.pm, __ATOMIC_RELAXED, __HIP_MEMORY_SCOPE_AGENT)) >= want) break;
                if (__builtin_amdgcn_s_memrealtime() - t0 > 2000000ull) {
                    if (lane == 0) { unsigned expect = 0u; __hip_atomic_compare_exchange_strong(tmo + 1, &expect, code | (unsigned)(u.pm & 0xff), __ATOMIC_RELAXED, __ATOMIC_RELAXED, __HIP_MEMORY_SCOPE_AGENT);
                                     __hip_atomic_store(tmo, 1u, __ATOMIC_RELAXED, __HIP_MEMORY_SCOPE_AGENT); }
                    dead = true; break; }
                __builtin_amdgcn_s_sleep(2);
            }
            __builtin_amdgcn_fence(__ATOMIC_ACQUIRE, "agent");
            if (lane == 0) flag[0] = dead ? 1u : 0u;
        }
        asm volatile("s_waitcnt vmcnt(0) lgkmcnt(0)" ::: "memory"); __builtin_amdgcn_s_barrier(); asm volatile("" ::: "memory");
        const bool bad = flag[0] != 0u;
        if (lane < 32) {
            const unsigned long long* slot = (const unsigned long long*)xbuf + (size_t)(u.pm * BM + row) * 4; float mt[4], m2[4]; float ms = 0.f;
#pragma unroll
            for (int t = 0; t < 4; ++t) { if (t < ntn) { const unsigned long long w = __hip_atomic_load(slot + t, __ATOMIC_RELAXED, __HIP_MEMORY_SCOPE_AGENT); mt[t] = __uint_as_float((unsigned)w); m2[t] = __uint_as_float((unsigned)(w >> 32)); } else { mt[t] = 0.f; m2[t] = 0.f; } ms += mt[t]; }
            const float mean = ms / (float)ntn; float q = 0.f;
#pragma unroll
            for (int t = 0; t < 4; ++t) if (t < ntn) { const float dm = mt[t] - mean; q += m2[t] + 256.0f * dm * dm; }
            S[row] = (f32x2v){mean, 1.0f / sqrtf(q / (256.0f * (float)ntn) + eps)};
        }
        asm volatile("s_waitcnt lgkmcnt(0)" ::: "memory"); __builtin_amdgcn_s_barrier(); asm volatile("" ::: "memory");
        return bad;
    }
};
struct EpiLnRes {
    static constexpr bool PERM = false, AFTER_DRAIN = true;
    const float* base; float* out; int ldc; const float* bias; PanelStats st; unsigned poison;
    __device__ __forceinline__ void fused(f32x4 (&acc)[2][2][4][2], const Unit& u, int wr, int wc, int fr, int fq, PG8_LAS unsigned char* lds, int wid, int lane) const {
        typedef float f32x2v __attribute__((ext_vector_type(2)));
        const PG8_LAS f32x2v* S = (const PG8_LAS f32x2v*)(lds + 8192);
        const int col0 = u.pn * BM + wc * 32 + 4 * fq;
#pragma unroll
        for (int bj = 0; bj < 2; ++bj)
#pragma unroll
            for (int n = 0; n < 2; ++n) { const f32x4 bv = bias ? *(const f32x4*)(bias + col0 + bj * HALF + n * 16) : (f32x4){0.f, 0.f, 0.f, 0.f};
#pragma unroll
                for (int ai = 0; ai < 2; ++ai)
#pragma unroll
                    for (int m = 0; m < 4; ++m) acc[ai][bj][m][n] += bv; }
        f32x4 pre[4][2][2];
#pragma unroll
        for (int m = 0; m < 4; ++m) { const size_t off = (size_t)(u.pm * BM + wr * 64 + m * 16 + fr) * ldc + col0;
#pragma unroll
            for (int bj = 0; bj < 2; ++bj)
#pragma unroll
                for (int n = 0; n < 2; ++n) pre[m][bj][n] = *(const f32x4*)(base + off + bj * HALF + n * 16); }
        const bool bad = st.run(acc, u, wr, wc, fr, fq, lds, wid, lane) || poison != 0u;
        const float qnan = __builtin_nanf("");
#pragma unroll
        for (int ai = 0; ai < 2; ++ai)
#pragma unroll
            for (int m = 0; m < 4; ++m) { const int r = ai * HALF + wr * 64 + m * 16 + fr; const f32x2v sr = S[r]; const size_t off = (size_t)(u.pm * BM + r) * ldc + col0;
#pragma unroll
                for (int bj = 0; bj < 2; ++bj)
#pragma unroll
                    for (int n = 0; n < 2; ++n) { const f32x4 bs = ai == 0 ? pre[m][bj][n] : *(const f32x4*)(base + off + bj * HALF + n * 16); f32x4 o = bs + (acc[ai][bj][m][n] - sr.x) * sr.y;
                        if (bad) o = (f32x4){qnan, qnan, qnan, qnan}; *(f32x4*)(out + off + bj * HALF + n * 16) = o; }
                if (m & 1) asm volatile("" ::: "memory"); }
    }
};
struct EpiLnResLn {
    static constexpr bool PERM = false, AFTER_DRAIN = true;
    const float* base; float* out; bf16_t* xn; int ldc; const float* bias; PanelStats st1, st2; unsigned poison;
    __device__ __forceinline__ void fused(f32x4 (&acc)[2][2][4][2], const Unit& u, int wr, int wc, int fr, int fq, PG8_LAS unsigned char* lds, int wid, int lane) const {
        typedef float f32x2v __attribute__((ext_vector_type(2))); typedef unsigned u32x2v __attribute__((ext_vector_type(2)));
        const PG8_LAS f32x2v* S = (const PG8_LAS f32x2v*)(lds + 8192);
        const int col0 = u.pn * BM + wc * 32 + 4 * fq;
#pragma unroll
        for (int bj = 0; bj < 2; ++bj)
#pragma unroll
            for (int n = 0; n < 2; ++n) { const f32x4 bv = bias ? *(const f32x4*)(bias + col0 + bj * HALF + n * 16) : (f32x4){0.f, 0.f, 0.f, 0.f};
#pragma unroll
                for (int ai = 0; ai < 2; ++ai)
#pragma unroll
                    for (int m = 0; m < 4; ++m) acc[ai][bj][m][n] += bv; }
        bool bad = st1.run(acc, u, wr, wc, fr, fq, lds, wid, lane) || poison != 0u;
        const float qnan = __builtin_nanf("");
#pragma unroll
        for (int ai = 0; ai < 2; ++ai)
#pragma unroll
            for (int m = 0; m < 4; ++m) { const int r = ai * HALF + wr * 64 + m * 16 + fr; const f32x2v sr = S[r]; const size_t off = (size_t)(u.pm * BM + r) * ldc + col0;
#pragma unroll
                for (int bj = 0; bj < 2; ++bj)
#pragma unroll
                    for (int n = 0; n < 2; ++n) { const f32x4 bs = *(const f32x4*)(base + off + bj * HALF + n * 16); acc[ai][bj][m][n] = bs + (acc[ai][bj][m][n] - sr.x) * sr.y; }
                asm volatile("" : "+v"(acc[ai][0][m][0]), "+v"(acc[ai][0][m][1]), "+v"(acc[ai][1][m][0]), "+v"(acc[ai][1][m][1]));
                if (m & 1) asm volatile("" ::: "memory"); }
        const bool bad1 = bad;
        bad = st2.run(acc, u, wr, wc, fr, fq, lds, wid, lane) || bad;
#pragma unroll
        for (int ai = 0; ai < 2; ++ai)
#pragma unroll
            for (int m = 0; m < 4; ++m) { const int r = ai * HALF + wr * 64 + m * 16 + fr; const f32x2v sr = S[r]; const size_t off = (size_t)(u.pm * BM + r) * ldc + col0;
#pragma unroll
                for (int bj = 0; bj < 2; ++bj)
#pragma unroll
                    for (int n = 0; n < 2; ++n) { const f32x4 x1 = acc[ai][bj][m][n]; *(f32x4*)(out + off + bj * HALF + n * 16) = bad1 ? (f32x4){qnan, qnan, qnan, qnan} : x1;
                        const f32x4 o = (x1 - sr.x) * sr.y; u32x2v w; w.x = cvt_pk_bf16(o[0], o[1]); w.y = cvt_pk_bf16(o[2], o[3]);
                        if (bad) { w.x = 0x7fc07fc0u; w.y = 0x7fc07fc0u; } *(u32x2v*)(xn + off + bj * HALF + n * 16) = w; }
                asm volatile("" ::: "memory"); }
    }
};

template <class Epi, class Sched, bool ALIGN_EPI = false, bool SP2 = false>
__device__ __forceinline__ void gemm_phase(PG8_LAS unsigned char* lds, const Gemm g, const Sched& S, const Epi& E) {
    const int tid = threadIdx.x, wid = __builtin_amdgcn_readfirstlane(tid >> 6), lane = tid & 63, wr = wid >> 2, wc = wid & 3, fr = lane & 15, fq = lane >> 4;
    const int K = g.K, nt = K / BK;
    unsigned voffA[2], voffB[2];
#pragma unroll
    for (int i = 0; i < 2; ++i) { int R, C; stage_rc(tid * 16 + i * 8192, R, C); const int Rb = Epi::PERM ? ((R & ~31) + perm32(R & 31)) : R;
        voffA[i] = (unsigned)(R * K + C) * 2u; voffB[i] = (unsigned)(Rb * K + C) * 2u; }
    const size_t kstep = (size_t)(BK * 2);
    const size_t hstep = (size_t)HALF * K * 2;
    const size_t tstep = 2 * hstep;
    const unsigned ldsw = (unsigned)wid * 1024u;
    const int aoff = lds_byte(wr * 64 + fr, fq * 8), boff = lds_byte(wc * 32 + fr, fq * 8);
#define PG8_SA(b, h) (((b) * 2 + (h)) * HTB)
#define PG8_SB(b, h) ((4 + (b) * 2 + (h)) * HTB)
#define PG8_STAGE(bufoff, gbase, voff) do { _Pragma("unroll") for (int _i = 0; _i < 2; ++_i) \
        __builtin_amdgcn_global_load_lds((const unsigned*)((const char*)(gbase) + (voff)[_i]), (PG8_LAS unsigned*)(lds + (bufoff) + ldsw + _i * 8192), 16, 0, 0); } while (0)
#define PG8_LDA(dst, b, h) do { _Pragma("unroll") for (int m = 0; m < 4; ++m) _Pragma("unroll") for (int k = 0; k < 2; ++k) dst[m][k] = *(const PG8_LAS bf16x8*)(lds + PG8_SA(b, h) + aoff + m * 2048 + k * 1024); } while (0)
#define PG8_LDB(dst, b, h) do { _Pragma("unroll") for (int n = 0; n < 2; ++n) _Pragma("unroll") for (int k = 0; k < 2; ++k) dst[n][k] = *(const PG8_LAS bf16x8*)(lds + PG8_SB(b, h) + boff + n * 2048 + k * 1024); } while (0)
#define PG8_MMA(ai, bj, At, Bt) do { __builtin_amdgcn_s_setprio(1); _Pragma("unroll") for (int m = 0; m < 4; ++m) _Pragma("unroll") for (int n = 0; n < 2; ++n) _Pragma("unroll") for (int k = 0; k < 2; ++k) \
        acc[ai][bj][m][n] = __builtin_amdgcn_mfma_f32_16x16x32_bf16(Bt[n][k], At[m][k], acc[ai][bj][m][n], 0, 0, 0); __builtin_amdgcn_s_setprio(0); } while (0)
#define PG8_WAIT_V(n) asm volatile("s_waitcnt vmcnt(" #n ")" ::: "memory")
#define PG8_WAIT_L(n) asm volatile("s_waitcnt lgkmcnt(" #n ")" ::: "memory")
#define PG8_BAR __builtin_amdgcn_s_barrier()
#define PG8_SCHED __builtin_amdgcn_sched_barrier(0)
    Unit cur, nxt; int ui = 0;
    if (!S.next(0, cur)) return;
    f32x4 acc[2][2][4][2];
#pragma unroll
    for (int a = 0; a < 2; ++a)
#pragma unroll
        for (int b = 0; b < 2; ++b)
#pragma unroll
            for (int m = 0; m < 4; ++m)
#pragma unroll
                for (int n = 0; n < 2; ++n) acc[a][b][m][n] = (f32x4){0.f, 0.f, 0.f, 0.f};
    bf16x8 At[4][2], B0[2][2], B1[2][2];
    const char* cA = (const char*)g.A + (size_t)cur.pm * tstep; const char* cB = (const char*)g.Bt + (size_t)cur.pn * tstep;
    S.a_ready(cur);
    if constexpr (SP2) {
        PG8_STAGE(PG8_SB(0, 0), cB, voffB); PG8_STAGE(PG8_SB(0, 1), cB + hstep, voffB); PG8_STAGE(PG8_SA(0, 0), cA, voffA); PG8_STAGE(PG8_SA(0, 1), cA + hstep, voffA);
        if (wr == 1) PG8_BAR;
        PG8_WAIT_V(2); PG8_BAR;
        PG8_STAGE(PG8_SB(1, 0), cB + kstep, voffB); PG8_STAGE(PG8_SA(1, 0), cA + kstep, voffA); PG8_STAGE(PG8_SB(1, 1), cB + hstep + kstep, voffB);
        PG8_WAIT_V(6); PG8_BAR;
    } else {
        PG8_STAGE(PG8_SB(0, 0), cB, voffB); PG8_STAGE(PG8_SA(0, 0), cA, voffA); PG8_STAGE(PG8_SB(0, 1), cB + hstep, voffB); PG8_STAGE(PG8_SA(0, 1), cA + hstep, voffA);
        if (wr == 1) PG8_BAR;
        PG8_WAIT_V(4); PG8_BAR;
        PG8_STAGE(PG8_SB(1, 0), cB + kstep, voffB); PG8_STAGE(PG8_SA(1, 0), cA + kstep, voffA); PG8_STAGE(PG8_SB(1, 1), cB + hstep + kstep, voffB);
        PG8_WAIT_V(6); PG8_BAR;
    }
    for (;;) {
        const bool has_next = S.next(ui + 1, nxt);
        const char* nA = has_next ? (const char*)g.A + (size_t)nxt.pm * tstep : cA; const char* nB = has_next ? (const char*)g.Bt + (size_t)nxt.pn * tstep : cB;
        for (int t = 0; t < nt; t += 2) {
            const bool last = (t == nt - 2);
            const char* a1 = cA + (size_t)(t + 1) * kstep;
            const char* a2 = last ? nA : cA + (size_t)(t + 2) * kstep; const char* b2 = last ? nB : cB + (size_t)(t + 2) * kstep;
            const char* a3 = a2 + kstep; const char* b3 = b2 + kstep;
            if (last && has_next) S.a_ready(nxt);
            if constexpr (SP2) {
            PG8_LDB(B0, 0, 0); PG8_LDB(B1, 0, 1); PG8_SCHED; PG8_LDA(At, 0, 0); PG8_STAGE(PG8_SA(1, 1), a1 + hstep, voffA);
            PG8_WAIT_V(8); PG8_WAIT_L(0); PG8_BAR; PG8_MMA(0, 0, At, B0); PG8_MMA(0, 1, At, B1); PG8_BAR; PG8_SCHED;
            PG8_LDA(At, 0, 1); PG8_STAGE(PG8_SB(0, 0), b2, voffB); PG8_STAGE(PG8_SB(0, 1), b2 + hstep, voffB); PG8_STAGE(PG8_SA(0, 0), a2, voffA);
            PG8_WAIT_V(8); PG8_WAIT_L(0); PG8_BAR; PG8_MMA(1, 0, At, B0); PG8_MMA(1, 1, At, B1); PG8_BAR; PG8_SCHED;
            PG8_LDB(B0, 1, 0); PG8_LDB(B1, 1, 1); PG8_SCHED; PG8_LDA(At, 1, 0); PG8_STAGE(PG8_SA(0, 1), a2 + hstep, voffA);
            PG8_WAIT_V(8); PG8_WAIT_L(0); PG8_BAR; PG8_MMA(0, 0, At, B0); PG8_MMA(0, 1, At, B1); PG8_BAR; PG8_SCHED;
            PG8_LDA(At, 1, 1); PG8_STAGE(PG8_SB(1, 0), b3, voffB); PG8_STAGE(PG8_SB(1, 1), b3 + hstep, voffB); PG8_STAGE(PG8_SA(1, 0), a3, voffA);
            PG8_WAIT_V(8); PG8_WAIT_L(0); PG8_BAR; PG8_MMA(1, 0, At, B0); PG8_MMA(1, 1, At, B1); PG8_BAR; PG8_SCHED;
            } else {
            PG8_LDB(B0, 0, 0); PG8_SCHED; PG8_LDA(At, 0, 0); PG8_STAGE(PG8_SA(1, 1), a1 + hstep, voffA);
            PG8_WAIT_L(8); PG8_BAR; PG8_WAIT_L(0); PG8_MMA(0, 0, At, B0); PG8_BAR; PG8_SCHED;
            PG8_LDB(B1, 0, 1); PG8_STAGE(PG8_SB(0, 0), b2, voffB);
            PG8_BAR; PG8_WAIT_L(0); PG8_MMA(0, 1, At, B1); PG8_BAR;
            PG8_LDA(At, 0, 1); PG8_STAGE(PG8_SA(0, 0), a2, voffA);
            PG8_BAR; PG8_WAIT_L(0); PG8_MMA(1, 0, At, B0); PG8_BAR; PG8_SCHED;
            PG8_STAGE(PG8_SB(0, 1), b2 + hstep, voffB);
            PG8_WAIT_V(6); PG8_BAR; PG8_MMA(1, 1, At, B1); PG8_BAR;
            PG8_LDB(B0, 1, 0); PG8_SCHED; PG8_LDA(At, 1, 0); PG8_STAGE(PG8_SA(0, 1), a2 + hstep, voffA);
            PG8_WAIT_L(8); PG8_BAR; PG8_WAIT_L(0); PG8_MMA(0, 0, At, B0); PG8_BAR; PG8_SCHED;
            PG8_LDB(B1, 1, 1); PG8_STAGE(PG8_SB(1, 0), b3, voffB);
            PG8_BAR; PG8_WAIT_L(0); PG8_MMA(0, 1, At, B1); PG8_BAR;
            PG8_LDA(At, 1, 1); PG8_STAGE(PG8_SA(1, 0), a3, voffA);
            PG8_BAR; PG8_WAIT_L(0); PG8_MMA(1, 0, At, B0); PG8_BAR; PG8_SCHED;
            PG8_STAGE(PG8_SB(1, 1), b3 + hstep, voffB);
            PG8_WAIT_V(6); PG8_BAR; PG8_MMA(1, 1, At, B1); PG8_BAR;
            }
        }
        if constexpr (ALIGN_EPI) { if (wr == 0) PG8_BAR; }
        if constexpr (!Epi::AFTER_DRAIN) { E(acc, cur, wr, wc, fr, fq); S.done(cur); }
        if (!has_next) break;
#pragma unroll
        for (int a = 0; a < 2; ++a)
#pragma unroll
            for (int b = 0; b < 2; ++b)
#pragma unroll
                for (int m = 0; m < 4; ++m)
#pragma unroll
                    for (int n = 0; n < 2; ++n) acc[a][b][m][n] = (f32x4){0.f, 0.f, 0.f, 0.f};
        cur = nxt; cA = nA; cB = nB; ++ui;
        if constexpr (ALIGN_EPI) { if (wr == 1) PG8_BAR; }
    }
    PG8_WAIT_V(0);
    if constexpr (!ALIGN_EPI) { if (wr == 0) PG8_BAR; }
    PG8_BAR;
    if constexpr (Epi::AFTER_DRAIN) { E.fused(acc, cur, wr, wc, fr, fq, lds, wid, lane); S.done(cur); }
#undef PG8_SA
#undef PG8_SB
#undef PG8_STAGE
#undef PG8_LDA
#undef PG8_LDB
#undef PG8_MMA
#undef PG8_WAIT_V
#undef PG8_WAIT_L
#undef PG8_BAR
#undef PG8_SCHED
}
}

#ifndef PG8_SP2
#define PG8_SP2 true
#endif
#ifndef PG8_ALIGN
#define PG8_ALIGN true
#endif

namespace pg8 {
struct OneUnit {
    bool has; Unit u;
    __device__ __forceinline__ bool next(int i, Unit& o) const { if (i > 0 || !has) return false; o = u; return true; }
    __device__ __forceinline__ void a_ready(const Unit&) const {}
    __device__ __forceinline__ void done(const Unit&) const {}
};
struct EpiProj {
    static constexpr bool PERM = true, AFTER_DRAIN = false;
    bf16_t* qkv; bf16_t* gates;
    __device__ __forceinline__ void operator()(const f32x4 (&acc)[2][2][4][2], const Unit& u, int wr, int wc, int fr, int fq) const {
        const int row0 = u.pm * BM + wr * 64 + fr; const int pn = u.pn;
        bf16_t* base; int ldc, colt; float sc = 1.f;
        if (pn < 14) { base = qkv; ldc = NQKV; colt = pn * BM; if (pn < 2 || pn == 6 || pn == 7) sc = C2; else if (pn >= 12) sc = C2M; }
        else { base = gates; ldc = NGATE; colt = (pn - 14) * BM; }
        const int col0 = colt + wc * 32 + 8 * fq;
#pragma unroll
        for (int ai = 0; ai < 2; ++ai)
#pragma unroll
            for (int m = 0; m < 4; ++m) { bf16_t* rowp = base + (size_t)(row0 + ai * HALF + m * 16) * ldc + col0;
#pragma unroll
                for (int bj = 0; bj < 2; ++bj) { const f32x4 v0 = acc[ai][bj][m][0] * sc, v1 = acc[ai][bj][m][1] * sc;
                    u32x4 w; w.x = cvt_pk_bf16(v0[0], v0[1]); w.y = cvt_pk_bf16(v0[2], v0[3]); w.z = cvt_pk_bf16(v1[0], v1[1]); w.w = cvt_pk_bf16(v1[2], v1[3]);
                    *(u32x4*)(rowp + bj * HALF) = w; } }
    }
};
struct EpiPlain {
    static constexpr bool PERM = true, AFTER_DRAIN = false;
    bf16_t* O; int ldc;
    __device__ __forceinline__ void operator()(const f32x4 (&acc)[2][2][4][2], const Unit& u, int wr, int wc, int fr, int fq) const {
        const int row0 = u.pm * BM + wr * 64 + fr; const int col0 = u.pn * BM + wc * 32 + 8 * fq;
#pragma unroll
        for (int ai = 0; ai < 2; ++ai)
#pragma unroll
            for (int m = 0; m < 4; ++m) { bf16_t* rowp = O + (size_t)(row0 + ai * HALF + m * 16) * ldc + col0;
#pragma unroll
                for (int bj = 0; bj < 2; ++bj) { const f32x4 v0 = acc[ai][bj][m][0], v1 = acc[ai][bj][m][1];
                    u32x4 w; w.x = cvt_pk_bf16(v0[0], v0[1]); w.y = cvt_pk_bf16(v0[2], v0[3]); w.z = cvt_pk_bf16(v1[0], v1[1]); w.w = cvt_pk_bf16(v1[2], v1[3]);
                    *(u32x4*)(rowp + bj * HALF) = w; } }
    }
};
}

#define GAS __attribute__((address_space(1)))
#define LAS __attribute__((address_space(3)))
typedef unsigned v4u __attribute__((ext_vector_type(4)));
typedef float f32x4 __attribute__((ext_vector_type(4)));
typedef short bf16x8 __attribute__((ext_vector_type(8)));
typedef GAS unsigned gu32;
typedef GAS unsigned long long gu64;
#define RLX_AGENT __ATOMIC_RELAXED, __HIP_MEMORY_SCOPE_AGENT
#define LDS_WAIT() asm volatile("s_waitcnt lgkmcnt(0)" ::: "memory")
#define VM_WAIT() asm volatile("s_waitcnt vmcnt(0)" ::: "memory")
__device__ __forceinline__ unsigned long long rt() { return __builtin_amdgcn_s_memrealtime(); }
__device__ __forceinline__ unsigned pk2(float lo, float hi) { return f2bf(lo) | (f2bf(hi) << 16); }

#define XB_TMO      128
#define XB_XCNT(j)  (256  + 64 * (j))
#define XB_XSUB(j)  (1280 + 64 * (j))
#define XB_XGEN(j)  (2304 + 64 * (j))
#define XB_TOP      3328
#define XB_TOPGEN   3392
#define XCD_BAR_WORDS 3456
#define XB_SPIN_CAP (1u << 18)

__device__ __forceinline__ unsigned xb_ld(unsigned* p)              { return __hip_atomic_load(p, __ATOMIC_RELAXED, __HIP_MEMORY_SCOPE_AGENT); }
__device__ __forceinline__ unsigned xb_add(unsigned* p, unsigned v) { return __hip_atomic_fetch_add(p, v, __ATOMIC_RELAXED, __HIP_MEMORY_SCOPE_AGENT); }
__device__ __forceinline__ unsigned xb_xcc_id() { return (unsigned)__builtin_amdgcn_s_getreg((3 << 11) | 20) & 0xFu; }
#define XB_SPIN(cond, bar) do { unsigned _sp = 0; while (cond) { __builtin_amdgcn_s_sleep(1); \
    if ((++_sp & 255u) == 0u) { if (xb_ld(&(bar)[XB_TMO])) break; if (_sp > XB_SPIN_CAP) { atomicAdd(&(bar)[XB_TMO], 1u); break; } } } } while (0)

struct XcdBarrier {
    unsigned* bar; unsigned x;
    volatile LAS unsigned* st;
};

__device__ __forceinline__ XcdBarrier xcd_barrier_post(unsigned* bar, volatile LAS unsigned* st) {
    XcdBarrier b; b.bar = bar; b.x = xb_xcc_id(); b.st = st;
    if (threadIdx.x == 0) (void)xb_add(&bar[XB_XCNT(b.x)], 1u);
    return b;
}
__device__ __forceinline__ void xcd_barrier_complete(unsigned* bar, unsigned x, unsigned& nloc, unsigned& nx) {
    const unsigned G = gridDim.x * gridDim.y * gridDim.z;
    unsigned sum, cnt, mine, sp = 0u;
    for (;;) {
        sum = 0u; cnt = 0u; mine = 0u;
#pragma unroll
        for (unsigned j = 0; j < 16; ++j) { const unsigned c = xb_ld(&bar[XB_XCNT(j)]); sum += c; cnt += (c > 0u) ? 1u : 0u; mine = (j == x) ? c : mine; }
        if (sum == G) break;
        __builtin_amdgcn_s_sleep(1);
        if ((++sp & 255u) == 0u) { if (xb_ld(&bar[XB_TMO])) break; if (sp > XB_SPIN_CAP) { atomicAdd(&bar[XB_TMO], 1u); break; } }
    }
    nloc = mine > 0u ? mine : 1u; nx = cnt > 0u ? cnt : 1u;
}

__device__ __forceinline__ void xcd_barrier(const XcdBarrier& b) {
    asm volatile("s_waitcnt vmcnt(0)" ::: "memory");
    __syncthreads();
    if (threadIdx.x == 0) {
        unsigned* bar = b.bar;
        __builtin_amdgcn_s_waitcnt(0);
        unsigned nloc = b.st[0], nx = b.st[1];
        if (nloc == 0u) { xcd_barrier_complete(bar, b.x, nloc, nx); b.st[0] = nloc; b.st[1] = nx; }
        const unsigned old = xb_add(&bar[XB_XSUB(b.x)], 1u);
        const unsigned gen = old / nloc;
        if (old + 1u == (gen + 1u) * nloc) {
            __builtin_amdgcn_fence(__ATOMIC_RELEASE, "agent");
            asm volatile("s_waitcnt vmcnt(0)" ::: "memory");
            const unsigned og = xb_add(&bar[XB_TOP], 1u);
            const unsigned tg = og / nx;
            if (og + 1u == (tg + 1u) * nx) xb_add(&bar[XB_TOPGEN], 1u);
            else XB_SPIN(xb_ld(&bar[XB_TOPGEN]) == tg, bar);
            __builtin_amdgcn_fence(__ATOMIC_ACQUIRE, "agent");
            xb_add(&bar[XB_XGEN(b.x)], 1u);
            asm volatile("s_waitcnt vmcnt(0)" ::: "memory");
        } else {
            XB_SPIN(xb_ld(&bar[XB_XGEN(b.x)]) == gen, bar);
            __builtin_amdgcn_fence(__ATOMIC_ACQUIRE, "agent");
            asm volatile("s_waitcnt vmcnt(0)" ::: "memory");
        }
    }
    __syncthreads();
}


constexpr int NWAVES = 8;
constexpr int RING_OFF = 0, RING_BYTES = 131072;
constexpr int LDSCTL_OFF = RING_BYTES, MISC_OFF = LDSCTL_OFF + 320;
constexpr int LDS_BYTES = 147456;
constexpr int CW_BAR = 4096;
constexpr int N_PHASES = 9;

struct Args { const float* in[26]; float* out; unsigned char* ws; int ph_lo, ph_hi, use_bar, pad; };

__device__ __forceinline__ void p0_transpose_item(const float* W, int ldw, int K, int N, bf16_t* WT, LAS float* scr, int item, int lane) {
    const int nblk = N / 32, kb = item / nblk, nb = item % nblk, k0 = 64 * kb, n0 = 32 * nb;
#pragma unroll 8
    for (int i = 0; i < 32; ++i) { const int kk = 2 * i + (lane >> 5); scr[kk * 33 + (lane & 31)] = W[(size_t)(k0 + kk) * ldw + n0 + (lane & 31)]; }
    LDS_WAIT(); asm volatile("" ::: "memory");
    const int c = lane & 7;
#pragma unroll
    for (int j = 0; j < 4; ++j) { const int n = (lane >> 3) + 8 * j; const LAS float* s = scr + (8 * c) * 33 + n;
        v4u o; o.x = pk2(s[0 * 33], s[1 * 33]); o.y = pk2(s[2 * 33], s[3 * 33]); o.z = pk2(s[4 * 33], s[5 * 33]); o.w = pk2(s[6 * 33], s[7 * 33]);
        *(GAS v4u*)(WT + (size_t)(n0 + n) * K + k0 + 8 * c) = o; }
    LDS_WAIT(); asm volatile("" ::: "memory");
}
__device__ __forceinline__ void row_to_bf16(const float* xrow, bf16_t* orow, int lane, f32x4 (&v)[4]) {
    const GAS f32x4* xr = (const GAS f32x4*)xrow + lane;
#pragma unroll
    for (int j = 0; j < 4; ++j) v[j] = xr[64 * j];
    GAS unsigned long long* o8 = (GAS unsigned long long*)orow + lane;
#pragma unroll
    for (int j = 0; j < 4; ++j) o8[64 * j] = (unsigned long long)pk2(v[j].x, v[j].y) | ((unsigned long long)pk2(v[j].z, v[j].w) << 32);
}

__device__ __forceinline__ void phase0(const Args& a, LAS unsigned char* L, int tid, int lane, int wave, int vcu, int G) {
    const float* x = a.in[0]; const float* mem = a.in[1]; const float* w_in = a.in[2]; const float* b_forget = a.in[3];
    unsigned char* ws = a.ws; unsigned char* dob = (unsigned char*)a.out;
    bf16_t* xb = (bf16_t*)(dob + DO_XB); bf16_t* win_t = (bf16_t*)(dob + DO_WIN_T); bf16_t* memb = (bf16_t*)(dob + DO_MEMB); bf16_t* wmkv_t = (bf16_t*)(dob + DO_WMKV_T);
    bf16_t* wbr_t = (bf16_t*)(ws + WS_WBR_T); bf16_t* wout_t = (bf16_t*)(ws + WS_WOUT_T); float* logf = (float*)(ws + WS_LOGF);
    LAS float* scr = (LAS float*)(L + RING_OFF + wave * 16384);
    const int gw = vcu * NWAVES + wave, NGW = G * NWAVES;
    constexpr int I_IN = (DM / 64) * (NPROJ / 32), I_MKV = (DM / 64) * (1024 / 32), I_BR = (512 / 64) * (DM / 32), I_OUT = (DM / 64) * (DM / 32);
    constexpr int NITEMS = I_IN + I_MKV + 3 * I_BR + I_OUT;
    for (int it = gw; it < NITEMS; it += NGW) {
        int r = it;
        if (r < I_IN) { p0_transpose_item(w_in, INCOLS, DM, NPROJ, win_t, scr, r, lane); continue; } r -= I_IN;
        if (r < I_MKV) { p0_transpose_item(a.in[10], 1024, DM, 1024, wmkv_t, scr, r, lane); continue; } r -= I_MKV;
        if (r < I_BR) { p0_transpose_item(a.in[11], DM, 512, DM, wbr_t, scr, r, lane); continue; } r -= I_BR;
        if (r < I_BR) { p0_transpose_item(a.in[12], DM, 512, DM, wbr_t + (size_t)DM * 512, scr, r, lane); continue; } r -= I_BR;
        if (r < I_BR) { p0_transpose_item(a.in[13], DM, 512, DM, wbr_t + (size_t)2 * DM * 512, scr, r, lane); continue; } r -= I_BR;
        p0_transpose_item(a.in[14], DM, DM, DM, wout_t, scr, r, lane);
    }
    __syncthreads();
    LAS float* wf = (LAS float*)(L + RING_OFF);
    for (int i = tid; i < 2048; i += NWAVES * 64) { const int k = i >> 1, hh = (i & 1) * 4; const f32x4 v = *(const GAS f32x4*)(w_in + (size_t)k * INCOLS + NPROJ + hh);
        wf[(hh + 0) * 1024 + k] = v.x; wf[(hh + 1) * 1024 + k] = v.y; wf[(hh + 2) * 1024 + k] = v.z; wf[(hh + 3) * 1024 + k] = v.w; }
    __syncthreads();
    for (int m = gw; m < T; m += NGW) {
        f32x4 v[4]; row_to_bf16(x + (size_t)m * DM, xb + (size_t)m * DM, lane, v);
        float acc[8];
#pragma unroll
        for (int h = 0; h < 8; ++h) { float s = 0.f;
#pragma unroll
            for (int j = 0; j < 4; ++j) { const f32x4 w = *(const LAS f32x4*)(wf + h * 1024 + 4 * (lane + 64 * j)); s += (v[j].x * w.x + v[j].y * w.y) + (v[j].z * w.z + v[j].w * w.w); }
            acc[h] = s; }
#pragma unroll
        for (int h = 0; h < 8; ++h) acc[h] = wave_sum(acc[h]);
        if (lane < 8) { float z = 0.f;
#pragma unroll
            for (int h = 0; h < 8; ++h) if (lane == h) z = acc[h];
            z += b_forget[lane];
            const int b = m / SEQ, s = m % SEQ;
            logf[(size_t)(b * 8 + lane) * SEQ + s] = fminf(z, 0.f) - log1pf(__expf(-fabsf(z))); }
    }
    for (int m = gw; m < NB * NMEM; m += NGW) { f32x4 v[4]; row_to_bf16(mem + (size_t)m * DM, memb + (size_t)m * DM, lane, v); }
}

__device__ __forceinline__ void cumsum_wave(const float* logf, float* fbias, int idx, int lane) {
    float carry = 0.f;
    for (int i = 0; i < SEQ / 64; ++i) {
        float inc = logf[(size_t)idx * SEQ + i * 64 + lane];
#pragma unroll
        for (int o = 1; o < 64; o <<= 1) { const float u = __shfl_up(inc, o); if (lane >= o) inc += u; }
        inc += carry;
        fbias[(size_t)idx * SEQ + i * 64 + lane] = -inc * LOG2E;
        carry = __shfl(inc, 63);
    }
}

__global__ void __launch_bounds__(NWAVES * 64, 2) mk_fwd(Args args) {
    extern __shared__ __attribute__((aligned(16))) unsigned char lds[];
    LAS unsigned char* L = (LAS unsigned char*)lds;
    volatile LAS unsigned* MISC = (volatile LAS unsigned*)(L + MISC_OFF);
    const int tid = threadIdx.x, lane = tid & 63, wave = __builtin_amdgcn_readfirstlane(tid >> 6);
    const int G = gridDim.x, bx = blockIdx.x, vcu = (G % 8 == 0) ? (bx % 8) * (G / 8) + bx / 8 : bx;
    unsigned char* ws = args.ws; unsigned char* dob = (unsigned char*)args.out;
    gu32* ctl = (gu32*)(ws + WS_CTL);
    for (int u = tid; u < (LDS_BYTES - LDSCTL_OFF) / 4; u += NWAVES * 64) ((LAS unsigned*)(L + LDSCTL_OFF))[u] = 0u;
    __syncthreads();
    XcdBarrier bar; bar.bar = (unsigned*)(ctl + CW_BAR); bar.x = 0; bar.st = nullptr;
    if (args.use_bar) bar = xcd_barrier_post((unsigned*)(ctl + CW_BAR), MISC + 8);
    const int lo = args.ph_lo, hi = args.ph_hi;
#define IN(k) (lo <= (k) && (k) < hi)
#define SEAM(k) do { if (IN(k) && IN((k) + 1)) xcd_barrier(bar); } while (0)

    bf16_t* xb = (bf16_t*)(dob + DO_XB); bf16_t* win_t = (bf16_t*)(dob + DO_WIN_T); bf16_t* memb = (bf16_t*)(dob + DO_MEMB); bf16_t* wmkv_t = (bf16_t*)(dob + DO_WMKV_T);
    bf16_t* qkv = (bf16_t*)(ws + WS_QKV); bf16_t* gates = (bf16_t*)(ws + WS_GATES);
    bf16_t* memk = (bf16_t*)(ws + WS_MEMK); bf16_t* memvt = (bf16_t*)(ws + WS_MEMVT);

    if (IN(0)) { phase0(args, L, tid, lane, wave, vcu, G); SEAM(0); }

    if (IN(1)) {
        if (bx >= 160 && bx < 192 && wave == 0) cumsum_wave((const float*)(ws + WS_LOGF), (float*)(ws + WS_FBIAS), bx - 160, lane);
        { pg8::Gemm g{xb, win_t, T, NPROJ, DM}; pg8::StaticOrder S; S.init(T, NPROJ, G, bx);
          pg8::EpiProj E{qkv, gates};
          pg8::gemm_phase<pg8::EpiProj, pg8::StaticOrder, PG8_ALIGN, PG8_SP2>(L + RING_OFF, g, S, E); }
        if (bx >= 144 && bx < 152) {
            pg8::Gemm g{memb, wmkv_t, 1024, 512, DM}; pg8::OneUnit S{true, {(bx - 144) >> 1, (bx - 144) & 1}};
            pg8::EpiPlain E{memk, 512};
            pg8::gemm_phase<pg8::EpiPlain, pg8::OneUnit, false, PG8_SP2>(L + RING_OFF, g, S, E); }
        if (bx >= 152 && bx < 160) {
            pg8::Gemm g{wmkv_t + (size_t)512 * DM, memb, 512, 1024, DM}; pg8::OneUnit S{true, {(bx - 152) >> 2, (bx - 152) & 3}};
            pg8::EpiPlain E{memvt, 1024};
            pg8::gemm_phase<pg8::EpiPlain, pg8::OneUnit, false, PG8_SP2>(L + RING_OFF, g, S, E); }
        SEAM(1);
    }
#undef IN
#undef SEAM
}

static int mk_setup() {
    static int grid = 0;
    if (grid == 0) {
        int dev = 0, cus = 0, per_cu = 0;
        if (hipGetDevice(&dev) != hipSuccess || hipDeviceGetAttribute(&cus, hipDeviceAttributeMultiprocessorCount, dev) != hipSuccess) { fprintf(stderr, "kernel_launch: device query failed\n"); grid = -1; return grid; }
        if (hipFuncSetAttribute((const void*)mk_fwd, hipFuncAttributeMaxDynamicSharedMemorySize, LDS_BYTES) != hipSuccess) { fprintf(stderr, "kernel_launch: hipFuncSetAttribute failed\n"); grid = -1; return grid; }
        if (hipOccupancyMaxActiveBlocksPerMultiprocessor(&per_cu, (const void*)mk_fwd, NWAVES * 64, LDS_BYTES) != hipSuccess || per_cu < 1) fprintf(stderr, "kernel_launch: occupancy query reports %d\n", per_cu);
        (void)hipGetLastError();
        grid = cus;
        if (grid != 256) fprintf(stderr, "kernel_launch: %d CUs (built for 256)\n", grid);
    }
    return grid;
}
static void mk_launch(const Args& base, int lo, int hi, hipStream_t stream) {
    const int grid = mk_setup(); if (grid <= 0) return;
    Args a = base; a.ph_lo = lo; a.ph_hi = hi; a.use_bar = (hi - lo > 1) ? 1 : 0; a.pad = 0;
    hipLaunchKernelGGL(mk_fwd, dim3(grid), dim3(NWAVES * 64), LDS_BYTES, stream, a);
}

extern "C" void kernel_launch(void* const* d_in, const int* in_sizes, int n_in, void* d_out, int out_size, void* d_ws, size_t ws_size, hipStream_t stream) {
    if (n_in != 26 || out_size != T * DM || ws_size < WS_END) { fprintf(stderr, "kernel_launch: unexpected sizes n_in %d out %d ws %zu\n", n_in, out_size, ws_size); return; }
    const float* x = (const float*)d_in[0]; const float* mem = (const float*)d_in[1]; const float* w_in = (const float*)d_in[2];
    const float* b_forget = (const float*)d_in[3]; const float* b_gates = (const float*)d_in[4];
    const float* lq1 = (const float*)d_in[5]; const float* lk1 = (const float*)d_in[6]; const float* lq2 = (const float*)d_in[7]; const float* lk2 = (const float*)d_in[8];
    const float* subln_g = (const float*)d_in[9]; const float* w_mem_kv = (const float*)d_in[10];
    const float* w_br[3] = {(const float*)d_in[11], (const float*)d_in[12], (const float*)d_in[13]}; const float* w_out = (const float*)d_in[14];
    const float* ln1_g = (const float*)d_in[15]; const float* ln1_b = (const float*)d_in[16];
    const float* wrg = (const float*)d_in[17]; const float* brg = (const float*)d_in[18]; const float* wre = (const float*)d_in[19]; const float* bre = (const float*)d_in[20];
    const float* weg = (const float*)d_in[21]; const float* weu = (const float*)d_in[22]; const float* wed = (const float*)d_in[23];
    const float* ln2_g = (const float*)d_in[24]; const float* ln2_b = (const float*)d_in[25];
    unsigned char* ws = (unsigned char*)d_ws; unsigned char* dob = (unsigned char*)d_out; float* out = (float*)d_out;
    u32* ctl = (u32*)(ws + WS_CTL);
    bf16_t* xb = (bf16_t*)(dob + DO_XB); bf16_t* win_t = (bf16_t*)(dob + DO_WIN_T); bf16_t* memb = (bf16_t*)(dob + DO_MEMB); bf16_t* wmkv_t = (bf16_t*)(dob + DO_WMKV_T);
    bf16_t* wbr_t = (bf16_t*)(ws + WS_WBR_T); bf16_t* wout_t = (bf16_t*)(ws + WS_WOUT_T);
    float* fbias = (float*)(ws + WS_FBIAS); float* logf = (float*)(ws + WS_LOGF);
    bf16_t* memk = (bf16_t*)(ws + WS_MEMK); bf16_t* memvt = (bf16_t*)(ws + WS_MEMVT);
    bf16_t* qkv = (bf16_t*)(ws + WS_QKV); bf16_t* gates = (bf16_t*)(ws + WS_GATES); bf16_t* hb = (bf16_t*)(ws + WS_HB); bf16_t* dpart = (bf16_t*)(ws + WS_DPART);
    bf16_t* yfox = (bf16_t*)(dob + DO_YFOX); bf16_t* ymem = (bf16_t*)(dob + DO_YMEM); bf16_t* ydiff = (bf16_t*)(dob + DO_YDIFF);
    bf16_t* wgu_t = (bf16_t*)(ws + WS_WGU_T); bf16_t* wd_t = (bf16_t*)(ws + WS_WD_T); bf16_t* x1b = (bf16_t*)(ws + WS_X1B); bf16_t* ybuf = (bf16_t*)(ws + WS_YBUF);
    u32* route = (u32*)(ws + WS_ROUTE); int* lists = (int*)(ws + WS_LISTS);

    hipMemsetAsync(ws + WS_CTL, 0, CTL_ZERO_BYTES, stream);
    Args base{}; for (int i = 0; i < 26; ++i) base.in[i] = (const float*)d_in[i]; base.out = (float*)d_out; base.ws = (unsigned char*)d_ws;
    mk_launch(base, 0, 1, stream);
    mk_launch(base, 1, 2, stream);
    { AttnP p{qkv, fbias, yfox, dpart}; k_attn_naive<<<dim3(T, 24), 64, 0, stream>>>(p); }
    k_memattn_naive<<<dim3(T, 4), 64, 0, stream>>>(qkv, memk, memvt, ymem);
    k_diff_combine<<<T, 256, 0, stream>>>(dpart, lq1, lk1, lq2, lk2, subln_g, ydiff);
    k_transpose_cvt<<<dim3(DEXP / 32, DM / 32, NEXP), 256, 0, stream>>>(weg, (size_t)DM * DEXP, DM, DEXP, DEXP, 0, wgu_t, (size_t)512 * DM, 1);
    k_transpose_cvt<<<dim3(DEXP / 32, DM / 32, NEXP), 256, 0, stream>>>(weu, (size_t)DM * DEXP, DM, DEXP, DEXP, 0, wgu_t, (size_t)512 * DM, 2);
    k_transpose_cvt<<<dim3(DM / 32, DEXP / 32, NEXP), 256, 0, stream>>>(wed, (size_t)DEXP * DM, DEXP, DM, DM, 0, wd_t, (size_t)DM * DEXP, 0);
    { const bf16_t* ys[3] = {yfox, ydiff, ymem};
      for (int i = 0; i < 3; ++i) { GemmP p{}; p.A = ys[i]; p.Bt = wbr_t + (size_t)i * DM * 512; p.M = T; p.N = DM; p.K = 512; p.lda = 512; p.ldb = 512; p.o0 = hb; p.g = gates; p.bias = b_gates; p.aux = i;
          k_gemm_naive<MODE_BRANCH><<<dim3(DM / 64, T / 64), 256, 0, stream>>>(p); } }
    { GemmP p{}; p.A = hb; p.Bt = wout_t; p.M = T; p.N = DM; p.K = DM; p.lda = DM; p.ldb = DM; p.xres = x; p.of = out;
      k_gemm_naive<MODE_OUT><<<dim3(DM / 64, T / 64), 256, 0, stream>>>(p); }
    { RouteP p{out, x1b, ln1_g, ln1_b, wrg, brg, wre, bre, ctl + CW_CNT, lists, route}; k_ln1_route<<<T / 4, 256, 0, stream>>>(p); }
    k_moe_naive<<<T * 2, 256, 0, stream>>>(x1b, wgu_t, wd_t, route, ybuf);
    k_final<<<T / 4, 256, 0, stream>>>(out, ybuf, ln2_g, ln2_b);
}
```
